# Optimizing an MI355X kernel written in HIP

```python
import jax, jax.numpy as jnp
from jax import lax
import numpy as np

D_MODEL = 1024
BATCH = 16
SEQ = 2048
DEPTH = 1

D_FF = 2816
MLSTM_HEADS = 4
MLSTM_DQK = 128
MLSTM_DV = 256
MLSTM_CHUNK = 64
CONV_WIDTH = 4
FOX_HEADS = 16
FOX_DH = 64
FOX_BLOCK = 128
N_MOD = 9
EPS = 1e-6
MLSTM_QK = MLSTM_HEADS * MLSTM_DQK
MLSTM_V = MLSTM_HEADS * MLSTM_DV
FOX_W = FOX_HEADS * FOX_DH
MIX_SPLITS = (MLSTM_QK, MLSTM_QK, MLSTM_V, MLSTM_V, MLSTM_HEADS, MLSTM_HEADS, FOX_W, FOX_W, FOX_W, FOX_HEADS, D_MODEL, D_MODEL)
MIX_WIDTH = 2 * MLSTM_QK + 2 * MLSTM_V + 2 * MLSTM_HEADS + 3 * FOX_W + FOX_HEADS + 2 * D_MODEL

kernel_name = "hybrid_mlstm_fox_macaron_adaln"


def _mix_offsets():
    offs = [0]
    for s in MIX_SPLITS:
        offs.append(offs[-1] + s)
    return offs


def rms_norm(x, g):
    xf = x.astype(jnp.float32)
    y = xf * lax.rsqrt(jnp.mean(xf * xf, axis=-1, keepdims=True) + EPS)
    return (y * g.astype(jnp.float32)).astype(x.dtype)


def swiglu(u, w_in, w_out):
    a, b = jnp.split(u @ w_in, 2, axis=-1)
    return (jax.nn.silu(a) * b) @ w_out


def causal_conv(x, w, b):
    y = lax.conv_general_dilated(x, w[:, None, :], window_strides=(1,), padding=[(CONV_WIDTH - 1, 0)],
                                 dimension_numbers=('NWC', 'WIO', 'NWC'), feature_group_count=x.shape[-1])
    return y + b


def mlstm_chunkwise(q, k, v, i_pre, f_pre):
    B, S, H, _ = q.shape
    L = MLSTM_CHUNK
    nc = S // L
    f32 = jnp.float32

    def to_chunks(t):
        t = jnp.moveaxis(t.astype(f32), 2, 1)
        t = t.reshape((B, H, nc, L) + t.shape[3:])
        return jnp.moveaxis(t, 2, 0)

    qc = to_chunks(q)
    kc = to_chunks(k) * (MLSTM_DQK ** -0.5)
    vc = to_chunks(v)
    ic = to_chunks(i_pre)
    lfc = to_chunks(jax.nn.log_sigmoid(f_pre.astype(f32)))
    causal = jnp.tril(jnp.ones((L, L), dtype=bool))

    def step(carry, inp):
        C, n, m = carry
        qt, kt, vt, it, lft = inp
        b = jnp.cumsum(lft, axis=-1)
        log_d = jnp.where(causal, b[..., :, None] - b[..., None, :] + it[..., None, :], -jnp.inf)
        log_inter = b + m[..., None]
        m_t = jnp.maximum(log_inter, jnp.max(log_d, axis=-1))
        w_inter = jnp.exp(log_inter - m_t)
        s = jnp.einsum('bhtd,bhsd->bhts', qt, kt) * jnp.exp(log_d - m_t[..., None])
        num = w_inter[..., None] * jnp.einsum('bhtd,bhde->bhte', qt, C) + jnp.einsum('bhts,bhse->bhte', s, vt)
        den = w_inter * jnp.einsum('bhtd,bhd->bht', qt, n) + jnp.sum(s, axis=-1)
        h = num / jnp.maximum(jnp.abs(den), jnp.exp(-m_t))[..., None]
        b_last = b[..., -1]
        log_w = b_last[..., None] - b + it
        m_new = jnp.maximum(b_last + m, jnp.max(log_w, axis=-1))
        w_k = jnp.exp(log_w - m_new[..., None])
        decay = jnp.exp(b_last + m - m_new)
        C_new = decay[..., None, None] * C + jnp.einsum('bhs,bhsd,bhse->bhde', w_k, kt, vt)
        n_new = decay[..., None] * n + jnp.einsum('bhs,bhsd->bhd', w_k, kt)
        return (C_new, n_new, m_new), h

    init = (jnp.zeros((B, H, MLSTM_DQK, MLSTM_DV), f32), jnp.zeros((B, H, MLSTM_DQK), f32), jnp.zeros((B, H), f32))
    _, h = lax.scan(step, init, (qc, kc, vc, ic, lfc))
    h = jnp.moveaxis(h, 0, 2).reshape(B, H, S, MLSTM_DV)
    return jnp.moveaxis(h, 1, 2)


def forgetting_attention(q, k, v, f_pre, q_g, k_g):
    B, S, H, Dh = q.shape
    f32 = jnp.float32
    q = jnp.moveaxis(rms_norm(q, q_g), 1, 2)
    k = jnp.moveaxis(rms_norm(k, k_g), 1, 2)
    v = jnp.moveaxis(v, 1, 2)
    F = jnp.moveaxis(jnp.cumsum(jax.nn.log_sigmoid(f_pre.astype(f32)), axis=1), 1, 2)
    nb = S // FOX_BLOCK
    qb = jnp.moveaxis(q.reshape(B, H, nb, FOX_BLOCK, Dh), 2, 0)
    Fb = jnp.moveaxis(F.reshape(B, H, nb, FOX_BLOCK), 2, 0)
    k_pos = jnp.arange(S)
    scale = Dh ** -0.5

    def block(args):
        q_blk, F_blk, blk_idx = args
        q_pos = blk_idx * FOX_BLOCK + jnp.arange(FOX_BLOCK)
        logits = jnp.einsum('bhqd,bhkd->bhqk', q_blk, k).astype(f32) * scale + (F_blk[..., :, None] - F[..., None, :])
        logits = jnp.where(k_pos[None, :] <= q_pos[:, None], logits, -jnp.inf)
        p = jax.nn.softmax(logits, axis=-1)
        return jnp.einsum('bhqk,bhkd->bhqd', p.astype(v.dtype), v)

    out = lax.map(block, (qb, Fb, jnp.arange(nb)))
    out = jnp.moveaxis(out, 0, 2).reshape(B, H, S, Dh)
    return jnp.moveaxis(out, 1, 2).reshape(B, S, H * Dh)


def hybrid_layer(x, c, w_ada, b_ada, ffn1_norm_g, ffn1_w_in, ffn1_w_out, mix_norm_g, w_mix, b_mix,
                 conv_w, conv_b, mlstm_norm_g, fox_q_norm_g, fox_k_norm_g, w_branch_a, w_branch_b, w_out,
                 ffn2_norm_g, ffn2_w_in, ffn2_w_out):
    B, S, _ = x.shape
    mod = jax.nn.silu(c) @ w_ada + b_ada
    sh1, sc1, g1, sh2, sc2, g2, sh3, sc3, g3 = [m[:, None, :] for m in jnp.split(mod, N_MOD, axis=-1)]

    u = rms_norm(x, ffn1_norm_g) * (1 + sc1) + sh1
    x = x + 0.5 * g1 * swiglu(u, ffn1_w_in, ffn1_w_out)

    u = rms_norm(x, mix_norm_g) * (1 + sc2) + sh2
    z = u @ w_mix + b_mix
    offs = _mix_offsets()
    q_m, k_m, v_m, o_m, i_m, f_m, q_f, k_f, v_f, f_f, g_a, g_b = [z[..., offs[j]:offs[j + 1]] for j in range(len(MIX_SPLITS))]

    qk_m = jax.nn.silu(causal_conv(jnp.concatenate([q_m, k_m], axis=-1), conv_w, conv_b))
    q_m, k_m = jnp.split(qk_m, 2, axis=-1)
    h_m = mlstm_chunkwise(q_m.reshape(B, S, MLSTM_HEADS, MLSTM_DQK), k_m.reshape(B, S, MLSTM_HEADS, MLSTM_DQK),
                          v_m.reshape(B, S, MLSTM_HEADS, MLSTM_DV), i_m, f_m)
    y_a = jax.nn.sigmoid(o_m) * rms_norm(h_m, mlstm_norm_g).reshape(B, S, MLSTM_V).astype(x.dtype)

    y_b = forgetting_attention(q_f.reshape(B, S, FOX_HEADS, FOX_DH), k_f.reshape(B, S, FOX_HEADS, FOX_DH),
                               v_f.reshape(B, S, FOX_HEADS, FOX_DH), f_f, fox_q_norm_g, fox_k_norm_g)

    merged = jax.nn.sigmoid(g_a) * (y_a @ w_branch_a) + jax.nn.sigmoid(g_b) * (y_b @ w_branch_b)
    x = x + g2 * (merged @ w_out)

    u = rms_norm(x, ffn2_norm_g) * (1 + sc3) + sh3
    x = x + 0.5 * g3 * swiglu(u, ffn2_w_in, ffn2_w_out)
    return x


def setup_inputs(seed: int = 0) -> dict:
    key = jax.random.key(seed)
    ks = jax.random.split(key, 24)
    f32 = jnp.float32
    L = DEPTH
    D = D_MODEL

    def nrm(k, shape, scale):
        return jax.random.normal(k, shape, f32) * scale

    def gain(k, shape):
        return 1.0 + 0.05 * jax.random.normal(k, shape, f32)

    offs = _mix_offsets()
    b_mix = nrm(ks[9], (L, MIX_WIDTH), 0.02)
    b_mix = b_mix.at[:, offs[5]:offs[6]].add(jnp.linspace(3.0, 6.0, MLSTM_HEADS))
    b_mix = b_mix.at[:, offs[9]:offs[10]].add(jnp.linspace(2.0, 7.0, FOX_HEADS))
    return {
        "x": nrm(ks[0], (BATCH, SEQ, D), 1.0),
        "c": nrm(ks[1], (BATCH, D), 1.0),
        "w_ada": nrm(ks[2], (L, D, N_MOD * D), 0.5 * D ** -0.5),
        "b_ada": nrm(ks[3], (L, N_MOD * D), 0.02),
        "ffn1_norm_g": gain(ks[4], (L, D)),
        "ffn1_w_in": nrm(ks[5], (L, D, 2 * D_FF), D ** -0.5),
        "ffn1_w_out": nrm(ks[6], (L, D_FF, D), D_FF ** -0.5),
        "mix_norm_g": gain(ks[7], (L, D)),
        "w_mix": nrm(ks[8], (L, D, MIX_WIDTH), D ** -0.5),
        "b_mix": b_mix,
        "conv_w": nrm(ks[10], (L, CONV_WIDTH, 2 * MLSTM_QK), CONV_WIDTH ** -0.5),
        "conv_b": nrm(ks[11], (L, 2 * MLSTM_QK), 0.02),
        "mlstm_norm_g": gain(ks[12], (L, MLSTM_HEADS, MLSTM_DV)),
        "fox_q_norm_g": gain(ks[13], (L, FOX_HEADS, FOX_DH)),
        "fox_k_norm_g": gain(ks[14], (L, FOX_HEADS, FOX_DH)),
        "w_branch_a": nrm(ks[15], (L, MLSTM_V, D), MLSTM_V ** -0.5),
        "w_branch_b": nrm(ks[16], (L, FOX_W, D), FOX_W ** -0.5),
        "w_out": nrm(ks[17], (L, D, D), D ** -0.5),
        "ffn2_norm_g": gain(ks[18], (L, D)),
        "ffn2_w_in": nrm(ks[19], (L, D, 2 * D_FF), D ** -0.5),
        "ffn2_w_out": nrm(ks[20], (L, D_FF, D), D_FF ** -0.5),
    }


def reference(x, c, w_ada, b_ada, ffn1_norm_g, ffn1_w_in, ffn1_w_out, mix_norm_g, w_mix, b_mix,
              conv_w, conv_b, mlstm_norm_g, fox_q_norm_g, fox_k_norm_g, w_branch_a, w_branch_b, w_out,
              ffn2_norm_g, ffn2_w_in, ffn2_w_out):
    for l in range(DEPTH):
        x = hybrid_layer(x, c, w_ada[l], b_ada[l], ffn1_norm_g[l], ffn1_w_in[l], ffn1_w_out[l], mix_norm_g[l],
                         w_mix[l], b_mix[l], conv_w[l], conv_b[l], mlstm_norm_g[l], fox_q_norm_g[l],
                         fox_k_norm_g[l], w_branch_a[l], w_branch_b[l], w_out[l], ffn2_norm_g[l],
                         ffn2_w_in[l], ffn2_w_out[l])
    return x
```

```cpp
#include <hip/hip_runtime.h>
#include <hip/hip_cooperative_groups.h>
#include <cstdio>
#include <cstdint>
namespace cg = cooperative_groups;
namespace pg8 {
#define PG8_LAS __attribute__((address_space(3)))
typedef unsigned short bf16_t;
typedef short bf16x8 __attribute__((ext_vector_type(8)));
typedef float f32x4 __attribute__((ext_vector_type(4)));
typedef unsigned u32x4 __attribute__((ext_vector_type(4)));
constexpr int BM = 256, BK = 64, HALF = 128, HTB = HALF * BK * 2  , STAGE_BYTES = 8 * HTB, NXCD = 8, WGM = 8;

__host__ __device__ __forceinline__ int lds_byte(int r, int c) { const int st = (r >> 4) * 2 + (c >> 5), rr = r & 15, cc = c & 31, ob = rr * 64 + cc * 2; return st * 1024 + (ob ^ (((ob >> 9) & 1) << 5)); }
__host__ __device__ __forceinline__ void stage_rc(int b, int& R, int& C) { const int st = b / 1024, sb = b % 1024, swz = sb ^ (((sb >> 9) & 1) << 5); R = (st >> 1) * 16 + swz / 64; C = (st & 1) * 32 + (swz % 64) / 2; }
__host__ __device__ __forceinline__ int perm32(int rho) { const int n = rho >> 4, i = rho & 15; return 8 * (i >> 2) + 4 * n + (i & 3); }

struct Unit { int pm, pn; };
struct Gemm { const bf16_t* A; const bf16_t* Bt; int M, N, K; };

struct StaticOrder {
    int nM, nN, nwg, G, c;
    __host__ __device__ void init(int M, int N, int G_, int c_) { nM = M / BM; nN = N / BM; nwg = nM * nN; G = G_; c = c_; }
    __host__ __device__ bool next(int i, Unit& u) const {
        const long L = (long)i * G + c; if (L >= nwg) return false;
        int wgid = (int)L; { const int q = nwg / NXCD, r = nwg % NXCD, xcd = wgid % NXCD, off = wgid / NXCD; wgid = (xcd < r ? xcd * (q + 1) : r * (q + 1) + (xcd - r) * q) + off; }
        const int nig = WGM * nN, gid = wgid / nig, fm = gid * WGM, gsz = (nM - fm) < WGM ? (nM - fm) : WGM;
        u.pm = fm + ((wgid % nig) % gsz); u.pn = (wgid % nig) / gsz; return true;
    }
    __device__ __forceinline__ void a_ready(const Unit&) const {}
    __device__ __forceinline__ void done(const Unit&) const {}
};
typedef float cvt_f32x2_t __attribute__((ext_vector_type(2))); typedef __bf16 cvt_bf16x2_t __attribute__((ext_vector_type(2)));
__device__ __forceinline__ unsigned cvt_pk_bf16(float lo, float hi) { const cvt_f32x2_t v = {lo, hi}; const cvt_bf16x2_t b = __builtin_convertvector(v, cvt_bf16x2_t); return __builtin_bit_cast(unsigned, b); }
typedef float f32x2 __attribute__((ext_vector_type(2)));
template <class Epi, class Sched, bool ALIGN_EPI = false, bool SP2 = false, bool SC1A = false, bool SC1B = false>
__device__ __forceinline__ void gemm_phase(PG8_LAS unsigned char* lds, const Gemm g, const Sched& S, const Epi& E) {
    int tid = threadIdx.x; asm volatile("" : "+v"(tid)); const int wid = __builtin_amdgcn_readfirstlane(tid >> 6), lane = tid & 63, wr = wid >> 2, wc = wid & 3, fr = lane & 15, fq = lane >> 4;
    const int K = g.K, nt = K / BK;
    unsigned voffA[2], voffB[2];
#pragma unroll
    for (int i = 0; i < 2; ++i) { int R, C; stage_rc(tid * 16 + i * 8192, R, C); const int Rb = Epi::PERM ? ((R & ~31) + perm32(R & 31)) : R;
        voffA[i] = (unsigned)(R * K + C) * 2u; voffB[i] = (unsigned)(Rb * K + C) * 2u; }
    const size_t kstep = (size_t)(BK * 2);
    const size_t hstep = (size_t)HALF * K * 2;
    const size_t tstep = 2 * hstep;
    const unsigned ldsw = (unsigned)wid * 1024u;
    const int aoff = lds_byte(wr * 64 + fr, fq * 8), boff = lds_byte(wc * 32 + fr, fq * 8);
#define PG8_SA(b, h) (((b) * 2 + (h)) * HTB)
#define PG8_SB(b, h) ((4 + (b) * 2 + (h)) * HTB)
#define PG8_STAGE_X(bufoff, gbase, voff, AUX) do { _Pragma("unroll") for (int _i = 0; _i < 2; ++_i) \
        __builtin_amdgcn_global_load_lds((const unsigned*)((const char*)(gbase) + (voff)[_i]), (PG8_LAS unsigned*)(lds + (bufoff) + ldsw + _i * 8192), 16, 0, AUX); } while (0)
#define PG8_STAGE_A(bufoff, gbase, voff) do { if constexpr (SC1A) PG8_STAGE_X(bufoff, gbase, voff, 16); else PG8_STAGE_X(bufoff, gbase, voff, 0); } while (0)
#define PG8_STAGE_B(bufoff, gbase, voff) do { if constexpr (SC1B) PG8_STAGE_X(bufoff, gbase, voff, 16); else PG8_STAGE_X(bufoff, gbase, voff, 0); } while (0)
#define PG8_LDA(dst, b, h) do { _Pragma("unroll") for (int m = 0; m < 4; ++m) _Pragma("unroll") for (int k = 0; k < 2; ++k) dst[m][k] = *(const PG8_LAS bf16x8*)(lds + PG8_SA(b, h) + aoff + m * 2048 + k * 1024); } while (0)
#define PG8_LDB(dst, b, h) do { _Pragma("unroll") for (int n = 0; n < 2; ++n) _Pragma("unroll") for (int k = 0; k < 2; ++k) dst[n][k] = *(const PG8_LAS bf16x8*)(lds + PG8_SB(b, h) + boff + n * 2048 + k * 1024); } while (0)
#define PG8_MMA(ai, bj, At, Bt) do { __builtin_amdgcn_s_setprio(1); _Pragma("unroll") for (int m = 0; m < 4; ++m) _Pragma("unroll") for (int n = 0; n < 2; ++n) _Pragma("unroll") for (int k = 0; k < 2; ++k) \
        acc[ai][bj][m][n] = __builtin_amdgcn_mfma_f32_16x16x32_bf16(Bt[n][k], At[m][k], acc[ai][bj][m][n], 0, 0, 0); __builtin_amdgcn_s_setprio(0); } while (0)
#define PG8_WAIT_V(n) asm volatile("s_waitcnt vmcnt(" #n ")" ::: "memory")
#define PG8_WAIT_L(n) asm volatile("s_waitcnt lgkmcnt(" #n ")" ::: "memory")
#define PG8_BAR __builtin_amdgcn_s_barrier()
#define PG8_SCHED __builtin_amdgcn_sched_barrier(0)
    Unit cur, nxt; int ui = 0;
    if (!S.next(0, cur)) return;
    f32x4 acc[2][2][4][2];
#pragma unroll
    for (int a = 0; a < 2; ++a)
#pragma unroll
        for (int b = 0; b < 2; ++b)
#pragma unroll
            for (int m = 0; m < 4; ++m)
#pragma unroll
                for (int n = 0; n < 2; ++n) acc[a][b][m][n] = (f32x4){0.f, 0.f, 0.f, 0.f};
    bf16x8 At[4][2], B0[2][2], B1[2][2];
    const char* cA = (const char*)g.A + (size_t)cur.pm * tstep; const char* cB = (const char*)g.Bt + (size_t)cur.pn * tstep;
    S.a_ready(cur);
    if constexpr (SP2) {
        PG8_STAGE_B(PG8_SB(0, 0), cB, voffB); PG8_STAGE_B(PG8_SB(0, 1), cB + hstep, voffB); PG8_STAGE_A(PG8_SA(0, 0), cA, voffA); PG8_STAGE_A(PG8_SA(0, 1), cA + hstep, voffA);
        if (wr == 1) PG8_BAR;
        PG8_WAIT_V(2); PG8_BAR;
        PG8_STAGE_B(PG8_SB(1, 0), cB + kstep, voffB); PG8_STAGE_A(PG8_SA(1, 0), cA + kstep, voffA); PG8_STAGE_B(PG8_SB(1, 1), cB + hstep + kstep, voffB);
        PG8_WAIT_V(6); PG8_BAR;
    } else {
        PG8_STAGE_B(PG8_SB(0, 0), cB, voffB); PG8_STAGE_A(PG8_SA(0, 0), cA, voffA); PG8_STAGE_B(PG8_SB(0, 1), cB + hstep, voffB); PG8_STAGE_A(PG8_SA(0, 1), cA + hstep, voffA);
        if (wr == 1) PG8_BAR;
        PG8_WAIT_V(4); PG8_BAR;
        PG8_STAGE_B(PG8_SB(1, 0), cB + kstep, voffB); PG8_STAGE_A(PG8_SA(1, 0), cA + kstep, voffA); PG8_STAGE_B(PG8_SB(1, 1), cB + hstep + kstep, voffB);
        PG8_WAIT_V(6); PG8_BAR;
    }
    for (;;) {
        const bool has_next = S.next(ui + 1, nxt);
        const char* nA = has_next ? (const char*)g.A + (size_t)nxt.pm * tstep : cA; const char* nB = has_next ? (const char*)g.Bt + (size_t)nxt.pn * tstep : cB;
        for (int t = 0; t < nt; t += 2) {
            const bool last = (t == nt - 2);
            const char* a1 = cA + (size_t)(t + 1) * kstep;
            const char* a2 = last ? nA : cA + (size_t)(t + 2) * kstep; const char* b2 = last ? nB : cB + (size_t)(t + 2) * kstep;
            const char* a3 = a2 + kstep; const char* b3 = b2 + kstep;
            if (last && has_next) S.a_ready(nxt);
            if constexpr (SP2) {
            PG8_LDB(B0, 0, 0); PG8_LDB(B1, 0, 1); PG8_SCHED; PG8_LDA(At, 0, 0); PG8_STAGE_A(PG8_SA(1, 1), a1 + hstep, voffA);
            PG8_WAIT_V(8); PG8_WAIT_L(0); PG8_BAR; PG8_MMA(0, 0, At, B0); PG8_MMA(0, 1, At, B1); PG8_BAR; PG8_SCHED;
            PG8_LDA(At, 0, 1); PG8_STAGE_B(PG8_SB(0, 0), b2, voffB); PG8_STAGE_B(PG8_SB(0, 1), b2 + hstep, voffB); PG8_STAGE_A(PG8_SA(0, 0), a2, voffA);
            PG8_WAIT_V(8); PG8_WAIT_L(0); PG8_BAR; PG8_MMA(1, 0, At, B0); PG8_MMA(1, 1, At, B1); PG8_BAR; PG8_SCHED;
            PG8_LDB(B0, 1, 0); PG8_LDB(B1, 1, 1); PG8_SCHED; PG8_LDA(At, 1, 0); PG8_STAGE_A(PG8_SA(0, 1), a2 + hstep, voffA);
            PG8_WAIT_V(8); PG8_WAIT_L(0); PG8_BAR; PG8_MMA(0, 0, At, B0); PG8_MMA(0, 1, At, B1); PG8_BAR; PG8_SCHED;
            PG8_LDA(At, 1, 1); PG8_STAGE_B(PG8_SB(1, 0), b3, voffB); PG8_STAGE_B(PG8_SB(1, 1), b3 + hstep, voffB); PG8_STAGE_A(PG8_SA(1, 0), a3, voffA);
            PG8_WAIT_V(8); PG8_WAIT_L(0); PG8_BAR; PG8_MMA(1, 0, At, B0); PG8_MMA(1, 1, At, B1); PG8_BAR; PG8_SCHED;
            } else {
            PG8_LDB(B0, 0, 0); PG8_SCHED; PG8_LDA(At, 0, 0); PG8_STAGE_A(PG8_SA(1, 1), a1 + hstep, voffA);
            PG8_WAIT_L(8); PG8_BAR; PG8_WAIT_L(0); PG8_MMA(0, 0, At, B0); PG8_BAR; PG8_SCHED;
            PG8_LDB(B1, 0, 1); PG8_STAGE_B(PG8_SB(0, 0), b2, voffB);
            PG8_BAR; PG8_WAIT_L(0); PG8_MMA(0, 1, At, B1); PG8_BAR;
            PG8_LDA(At, 0, 1); PG8_STAGE_A(PG8_SA(0, 0), a2, voffA);
            PG8_BAR; PG8_WAIT_L(0); PG8_MMA(1, 0, At, B0); PG8_BAR; PG8_SCHED;
            PG8_STAGE_B(PG8_SB(0, 1), b2 + hstep, voffB);
            PG8_WAIT_V(6); PG8_BAR; PG8_MMA(1, 1, At, B1); PG8_BAR;
            PG8_LDB(B0, 1, 0); PG8_SCHED; PG8_LDA(At, 1, 0); PG8_STAGE_A(PG8_SA(0, 1), a2 + hstep, voffA);
            PG8_WAIT_L(8); PG8_BAR; PG8_WAIT_L(0); PG8_MMA(0, 0, At, B0); PG8_BAR; PG8_SCHED;
            PG8_LDB(B1, 1, 1); PG8_STAGE_B(PG8_SB(1, 0), b3, voffB);
            PG8_BAR; PG8_WAIT_L(0); PG8_MMA(0, 1, At, B1); PG8_BAR;
            PG8_LDA(At, 1, 1); PG8_STAGE_A(PG8_SA(1, 0), a3, voffA);
            PG8_BAR; PG8_WAIT_L(0); PG8_MMA(1, 0, At, B0); PG8_BAR; PG8_SCHED;
            PG8_STAGE_B(PG8_SB(1, 1), b3 + hstep, voffB);
            PG8_WAIT_V(6); PG8_BAR; PG8_MMA(1, 1, At, B1); PG8_BAR;
            }
        }
        if constexpr (ALIGN_EPI) { if (wr == 0) PG8_BAR; }
        if constexpr (!Epi::AFTER_DRAIN) { E(acc, cur, wr, wc, fr, fq); S.done(cur); }
        if (!has_next) break;
#pragma unroll
        for (int a = 0; a < 2; ++a)
#pragma unroll
            for (int b = 0; b < 2; ++b)
#pragma unroll
                for (int m = 0; m < 4; ++m)
#pragma unroll
                    for (int n = 0; n < 2; ++n) acc[a][b][m][n] = (f32x4){0.f, 0.f, 0.f, 0.f};
        cur = nxt; cA = nA; cB = nB; ++ui;
        if constexpr (ALIGN_EPI) { if (wr == 1) PG8_BAR; }
    }
    PG8_WAIT_V(0);
    if constexpr (!ALIGN_EPI) { if (wr == 0) PG8_BAR; }
    PG8_BAR;
    if constexpr (Epi::AFTER_DRAIN) { E.fused(acc, cur, wr, wc, fr, fq, lds, wid, lane); S.done(cur); }
#undef PG8_SA
#undef PG8_SB
#undef PG8_STAGE_X
#undef PG8_STAGE_A
#undef PG8_STAGE_B
#undef PG8_LDA
#undef PG8_LDB
#undef PG8_MMA
#undef PG8_WAIT_V
#undef PG8_WAIT_L
#undef PG8_BAR
#undef PG8_SCHED
}
}

#ifndef MK_SINGLE
#define MK_SINGLE 1
#endif
#define LAS __attribute__((address_space(3)))
using pg8::bf16_t; using pg8::bf16x8; using pg8::f32x4; using pg8::cvt_pk_bf16;
typedef float f32x16 __attribute__((ext_vector_type(16)));
typedef unsigned u32x4 __attribute__((ext_vector_type(4)));
typedef unsigned u32x2 __attribute__((ext_vector_type(2)));
constexpr int NB = 16, SEQ = 2048, DM = 1024, MTOK = NB * SEQ, DFF = 2816, MIXW = 8216, MODW = 9216;
constexpr float EPS = 1e-6f, LOG2E = 1.4426950408889634f;
constexpr size_t MiB = 1u << 20;
constexpr size_t WS_MOD = 0, WS_CNT = 1 * MiB, WS_GATES = 2 * MiB, WS_FC = 6 * MiB,
    WS_BTZ = 8 * MiB, WS_WVT = 17 * MiB, WS_BTG = 21 * MiB, WS_BTA = 25 * MiB, WS_BTB = 27 * MiB, WS_BTO = 29 * MiB, WS_BT2I = 31 * MiB, WS_BT2O = 42 * MiB,
    WS_U = 48 * MiB, WS_QKM = 112 * MiB, WS_VTM = 176 * MiB, WS_OM = 240 * MiB, WS_QF = 304 * MiB, WS_KF = 368 * MiB, WS_VTF = 432 * MiB, WS_END = 496 * MiB,
    WS_HID = 112 * MiB, WS_BT1I = 288 * MiB, WS_BT1O = 299 * MiB, WS_T = 112 * MiB, WS_SG = 368 * MiB, WS_MRG = 48 * MiB, WS_GV = 496 * MiB, WS_NEED = 498 * MiB;
constexpr int LDS_BYTES = 147456, LDS_ITEM = 143360;

__device__ __forceinline__ float bflo(unsigned u) { return __uint_as_float(u << 16); }
__device__ __forceinline__ float bfhi(unsigned u) { return __uint_as_float(u & 0xffff0000u); }
__device__ __forceinline__ float sigmoid_f(float v) { return __builtin_amdgcn_rcpf(1.f + __expf(-v)); }
__device__ __forceinline__ float silu_f(float v) { return v * sigmoid_f(v); }
__device__ __forceinline__ float logsig_f(float f) { return fminf(f, 0.f) - log1pf(expf(-fabsf(f))); }
__device__ __forceinline__ float wave_sum(float v) {
#pragma unroll
    for (int o = 1; o < 64; o <<= 1) v += __shfl_xor(v, o);
    return v;
}
__device__ __forceinline__ u32x4 pack8(const float* v) { u32x4 w; w.x = cvt_pk_bf16(v[0], v[1]); w.y = cvt_pk_bf16(v[2], v[3]); w.z = cvt_pk_bf16(v[4], v[5]); w.w = cvt_pk_bf16(v[6], v[7]); return w; }
__device__ __forceinline__ f32x16 mfma32(bf16x8 a, bf16x8 b, f32x16 c) { return __builtin_amdgcn_mfma_f32_32x32x16_bf16(a, b, c, 0, 0, 0); }
__device__ __forceinline__ f32x4 mfma16(bf16x8 a, bf16x8 b, f32x4 c) { return __builtin_amdgcn_mfma_f32_16x16x32_bf16(a, b, c, 0, 0, 0); }


__device__ __forceinline__ void st16(void* p, u32x4 v) { asm volatile("global_store_dwordx4 %0, %1, off sc1\n\ts_nop 1" :: "v"(p), "v"(v)); }
__device__ __forceinline__ void st16f(void* p, f32x4 v) { asm volatile("global_store_dwordx4 %0, %1, off sc1\n\ts_nop 1" :: "v"(p), "v"(v)); }
__device__ __forceinline__ void st8(void* p, u32x2 v) { asm volatile("global_store_dwordx2 %0, %1, off sc1\n\ts_nop 1" :: "v"(p), "v"(v)); }

__device__ __forceinline__ u32x2 ld8c(const void* p) { const unsigned long long v = __hip_atomic_load((const unsigned long long*)p, __ATOMIC_RELAXED, __HIP_MEMORY_SCOPE_AGENT); u32x2 r; r.x = (unsigned)v; r.y = (unsigned)(v >> 32); return r; }
__device__ __forceinline__ u32x4 ld16c(const void* p) { const u32x2 a = ld8c(p), b = ld8c((const char*)p + 8); u32x4 r; r.x = a.x; r.y = a.y; r.z = b.x; r.w = b.y; return r; }
__device__ __forceinline__ f32x4 ld16cf(const void* p) { return __builtin_bit_cast(f32x4, ld16c(p)); }
__device__ __forceinline__ float ld4c(const float* p) { return __uint_as_float(__hip_atomic_load((const unsigned*)p, __ATOMIC_RELAXED, __HIP_MEMORY_SCOPE_AGENT)); }

struct CBuf { __amdgpu_buffer_rsrc_t rs; const unsigned char* base; };
__device__ __forceinline__ CBuf make_cbuf(const void* base, unsigned bytes) { CBuf c; c.rs = __builtin_amdgcn_make_buffer_rsrc((void*)base, (short)0, (int)bytes, 0x00020000); c.base = (const unsigned char*)base; return c; }
__device__ __forceinline__ u32x4 ld16b(const CBuf& c, const void* p) { return __builtin_amdgcn_raw_buffer_load_b128(c.rs, (unsigned)((const unsigned char*)p - c.base), 0, 16); }
__device__ __forceinline__ f32x4 ld16bf(const CBuf& c, const void* p) { return __builtin_bit_cast(f32x4, ld16b(c, p)); }
struct EpiSwiglu {
    static constexpr bool PERM = true, AFTER_DRAIN = false; bf16_t* O;
    __device__ __forceinline__ void operator()(const f32x4 (&acc)[2][2][4][2], const pg8::Unit& u, int wr, int wc, int fr, int fq) const {
        const int row0 = u.pm * 256 + wr * 64 + fr, col0 = u.pn * 128 + wc * 32 + 8 * fq;
#pragma unroll
        for (int ai = 0; ai < 2; ++ai)
#pragma unroll
            for (int m = 0; m < 4; ++m) {
                bf16_t* p = O + (size_t)(row0 + ai * 128 + m * 16) * DFF + col0;
                float hv[8];
#pragma unroll
                for (int n = 0; n < 2; ++n)
#pragma unroll
                    for (int j = 0; j < 4; ++j) hv[4 * n + j] = silu_f(acc[ai][0][m][n][j]) * acc[ai][1][m][n][j];
                st16(p, pack8(hv));
            }
    }
};
struct EpiRes {
    static constexpr bool PERM = false, AFTER_DRAIN = false; const float* base; float* out; const float* coef; float scale; CBuf cb; bool coh;
    __device__ __forceinline__ void operator()(const f32x4 (&acc)[2][2][4][2], const pg8::Unit& u, int wr, int wc, int fr, int fq) const {
        const int col0 = u.pn * 256 + wc * 32 + 4 * fq; const float* cf = coef + (size_t)(u.pm >> 3) * MODW;
        f32x4 g[2][2];
#pragma unroll
        for (int bj = 0; bj < 2; ++bj)
#pragma unroll
            for (int n = 0; n < 2; ++n) g[bj][n] = *(const f32x4*)(cf + col0 + bj * 128 + n * 16) * scale;
#pragma unroll
        for (int ai = 0; ai < 2; ++ai)
#pragma unroll
            for (int mp = 0; mp < 2; ++mp) {
                f32x4 bs[2][2][2];
#pragma unroll
                for (int mm = 0; mm < 2; ++mm) { const size_t off = (size_t)(u.pm * 256 + ai * 128 + wr * 64 + (2 * mp + mm) * 16 + fr) * DM + col0;
#pragma unroll
                    for (int bj = 0; bj < 2; ++bj)
#pragma unroll
                        for (int n = 0; n < 2; ++n) { const size_t o = off + bj * 128 + n * 16; bs[mm][bj][n] = coh ? ld16bf(cb, base + o) : *(const f32x4*)(base + o); } }
#pragma unroll
                for (int mm = 0; mm < 2; ++mm) { const size_t off = (size_t)(u.pm * 256 + ai * 128 + wr * 64 + (2 * mp + mm) * 16 + fr) * DM + col0;
#pragma unroll
                    for (int bj = 0; bj < 2; ++bj)
#pragma unroll
                        for (int n = 0; n < 2; ++n) st16f(out + off + bj * 128 + n * 16, bs[mm][bj][n] + g[bj][n] * acc[ai][bj][2 * mp + mm][n]); }
            }
    }
};
struct EpiZ {
    static constexpr bool PERM = true, AFTER_DRAIN = false; unsigned char* ws; const float* bmix;
    __device__ __forceinline__ void operator()(const f32x4 (&acc)[2][2][4][2], const pg8::Unit& u, int wr, int wc, int fr, int fq) const {
        const int pn = u.pn, rowb = u.pm * 256 + wr * 64 + fr;
        if (pn < 16) {
            const int seg = pn >> 2; bf16_t* base = (bf16_t*)(ws + (seg == 0 ? WS_QKM : WS_OM + (size_t)(seg - 1) * 64 * MiB));
            const int boff = seg == 0 ? 0 : seg == 1 ? 2048 : seg == 2 ? 3080 : 4104;
            const int col0 = (pn & 3) * 256 + wc * 32 + 8 * fq;
            f32x4 bv[2][2];
#pragma unroll
            for (int bj = 0; bj < 2; ++bj)
#pragma unroll
                for (int n = 0; n < 2; ++n) bv[bj][n] = *(const f32x4*)(bmix + boff + col0 + bj * 128 + 4 * n);
#pragma unroll
            for (int ai = 0; ai < 2; ++ai)
#pragma unroll
                for (int m = 0; m < 4; ++m) { bf16_t* rowp = base + (size_t)(rowb + ai * 128 + m * 16) * DM + col0;
#pragma unroll
                    for (int bj = 0; bj < 2; ++bj) { const f32x4 v0 = acc[ai][bj][m][0] + bv[bj][0], v1 = acc[ai][bj][m][1] + bv[bj][1];
                        u32x4 w; w.x = cvt_pk_bf16(v0[0], v0[1]); w.y = cvt_pk_bf16(v0[2], v0[3]); w.z = cvt_pk_bf16(v1[0], v1[1]); w.w = cvt_pk_bf16(v1[2], v1[3]);
                        st16(rowp + bj * 128, w); } }
        } else if (wc == 0) {
            float* G = (float*)(ws + WS_GATES);
#pragma unroll
            for (int n = 0; n < 2; ++n) { const int lc0 = 8 * fq + 4 * n;
                f32x4 bb = (f32x4){0.f, 0.f, 0.f, 0.f};
                if (lc0 < 8) bb = *(const f32x4*)(bmix + 3072 + lc0); else if (lc0 < 24) bb = *(const f32x4*)(bmix + 6152 + lc0 - 8);
#pragma unroll
                for (int ai = 0; ai < 2; ++ai)
#pragma unroll
                    for (int m = 0; m < 4; ++m) st16f(G + (size_t)(rowb + ai * 128 + m * 16) * 32 + lc0, acc[ai][0][m][n] + bb); }
        }
    }
};
struct EpiVT {
    static constexpr bool PERM = true, AFTER_DRAIN = false; unsigned char* ws; const float* bmix;
    __device__ __forceinline__ void operator()(const f32x4 (&acc)[2][2][4][2], const pg8::Unit& u, int wr, int wc, int fr, int fq) const {
        const bool isf = u.pm >= 4; bf16_t* base = (bf16_t*)(ws + (isf ? WS_VTF : WS_VTM)); const int boff = isf ? 5128 : 1024;
        const int rl0 = (u.pm & 3) * 256 + wr * 64 + fr, col0 = u.pn * 256 + wc * 32 + 8 * fq;
#pragma unroll
        for (int ai = 0; ai < 2; ++ai)
#pragma unroll
            for (int m = 0; m < 4; ++m) { const int rl = rl0 + ai * 128 + m * 16; const float bs = bmix[boff + rl]; bf16_t* rowp = base + (size_t)rl * MTOK + col0;
#pragma unroll
                for (int bj = 0; bj < 2; ++bj) { const f32x4 v0 = acc[ai][bj][m][0] + bs, v1 = acc[ai][bj][m][1] + bs;
                    u32x4 w; w.x = cvt_pk_bf16(v0[0], v0[1]); w.y = cvt_pk_bf16(v0[2], v0[3]); w.z = cvt_pk_bf16(v1[0], v1[1]); w.w = cvt_pk_bf16(v1[2], v1[3]);
                    st16(rowp + bj * 128, w); } }
    }
};
struct EpiSig {
    static constexpr bool PERM = true, AFTER_DRAIN = false; bf16_t* SG; const float* bmix;
    __device__ __forceinline__ void operator()(const f32x4 (&acc)[2][2][4][2], const pg8::Unit& u, int wr, int wc, int fr, int fq) const {
        const int rowb = u.pm * 256 + wr * 64 + fr, col0 = u.pn * 256 + wc * 32 + 8 * fq;
        f32x4 bv[2][2];
#pragma unroll
        for (int bj = 0; bj < 2; ++bj)
#pragma unroll
            for (int n = 0; n < 2; ++n) bv[bj][n] = *(const f32x4*)(bmix + 6168 + col0 + bj * 128 + 4 * n);
#pragma unroll
        for (int ai = 0; ai < 2; ++ai)
#pragma unroll
            for (int m = 0; m < 4; ++m) { bf16_t* rowp = SG + (size_t)(rowb + ai * 128 + m * 16) * 2048 + col0;
#pragma unroll
                for (int bj = 0; bj < 2; ++bj) { float hv[8];
#pragma unroll
                    for (int n = 0; n < 2; ++n)
#pragma unroll
                        for (int j = 0; j < 4; ++j) hv[4 * n + j] = sigmoid_f(acc[ai][bj][m][n][j] + bv[bj][n][j]);
                    st16(rowp + bj * 128, pack8(hv)); } }
    }
};
struct EpiMul {
    static constexpr bool PERM = false, AFTER_DRAIN = false; const bf16_t* SG; bf16_t* T;
    __device__ __forceinline__ void operator()(const f32x4 (&acc)[2][2][4][2], const pg8::Unit& u, int wr, int wc, int fr, int fq) const {
        const int col0 = u.pn * 256 + wc * 32 + 4 * fq;
#pragma unroll
        for (int ai = 0; ai < 2; ++ai) {
            u32x2 g[4][2][2];
#pragma unroll
            for (int m = 0; m < 4; ++m) { const size_t r = (size_t)(u.pm * 256 + ai * 128 + wr * 64 + m * 16 + fr);
#pragma unroll
                for (int bj = 0; bj < 2; ++bj)
#pragma unroll
                    for (int n = 0; n < 2; ++n) g[m][bj][n] = ld8c(SG + r * 2048 + col0 + bj * 128 + n * 16); }
#pragma unroll
            for (int m = 0; m < 4; ++m) { const size_t r = (size_t)(u.pm * 256 + ai * 128 + wr * 64 + m * 16 + fr);
#pragma unroll
                for (int bj = 0; bj < 2; ++bj)
#pragma unroll
                    for (int n = 0; n < 2; ++n) { const int c = col0 + bj * 128 + n * 16; const u32x2 gg = g[m][bj][n];
                        const f32x4 gv = (f32x4){bflo(gg.x), bfhi(gg.x), bflo(gg.y), bfhi(gg.y)}; const f32x4 tv = gv * acc[ai][bj][m][n];
                        u32x2 tw; tw.x = cvt_pk_bf16(tv[0], tv[1]); tw.y = cvt_pk_bf16(tv[2], tv[3]); st8(T + r * DM + c, tw); } }
        }
    }
};
struct EpiMerge {
    static constexpr bool PERM = false, AFTER_DRAIN = false; const bf16_t* SG; const bf16_t* T; bf16_t* O; CBuf cb;
    __device__ __forceinline__ void operator()(const f32x4 (&acc)[2][2][4][2], const pg8::Unit& u, int wr, int wc, int fr, int fq) const {
        const int col0 = u.pn * 256 + wc * 32 + 4 * fq;
#pragma unroll
        for (int ai = 0; ai < 2; ++ai) {
            u32x2 g[4][2][2], t[4][2][2];
#pragma unroll
            for (int m = 0; m < 4; ++m) { const size_t r = (size_t)(u.pm * 256 + ai * 128 + wr * 64 + m * 16 + fr);
#pragma unroll
                for (int bj = 0; bj < 2; ++bj)
#pragma unroll
                    for (int n = 0; n < 2; ++n) { const int c = col0 + bj * 128 + n * 16; g[m][bj][n] = ld8c(SG + r * 2048 + 1024 + c); t[m][bj][n] = ld8c(T + r * DM + c); } }
#pragma unroll
            for (int m = 0; m < 4; ++m) { const size_t r = (size_t)(u.pm * 256 + ai * 128 + wr * 64 + m * 16 + fr);
#pragma unroll
                for (int bj = 0; bj < 2; ++bj)
#pragma unroll
                    for (int n = 0; n < 2; ++n) { const int c = col0 + bj * 128 + n * 16; const u32x2 gg = g[m][bj][n], tq = t[m][bj][n];
                        const f32x4 gv = (f32x4){bflo(gg.x), bfhi(gg.x), bflo(gg.y), bfhi(gg.y)}, tv = (f32x4){bflo(tq.x), bfhi(tq.x), bflo(tq.y), bfhi(tq.y)};
                        const f32x4 v = tv + gv * acc[ai][bj][m][n]; u32x2 w; w.x = cvt_pk_bf16(v[0], v[1]); w.y = cvt_pk_bf16(v[2], v[3]); st8(O + r * DM + c, w); } }
        }
    }
};

__device__ __forceinline__ void tr_item(const float* W, int K, int N, int sc0, int k0, bf16_t* WT, int dr0, LAS float* scr, int lane) {
    f32x4 tv[16];
#pragma unroll
    for (int i = 0; i < 16; ++i) { const int kk = 4 * i + (lane >> 4); tv[i] = *(const f32x4*)(W + (size_t)(k0 + kk) * N + sc0 + 4 * (lane & 15)); }
#pragma unroll
    for (int i = 0; i < 16; ++i) { const int kk = 4 * i + (lane >> 4); LAS float* d = scr + kk * 65 + 4 * (lane & 15); d[0] = tv[i][0]; d[1] = tv[i][1]; d[2] = tv[i][2]; d[3] = tv[i][3]; }
    asm volatile("s_waitcnt lgkmcnt(0)" ::: "memory");
    const int c = lane & 7;
#pragma unroll
    for (int j = 0; j < 8; ++j) { const int n = (lane >> 3) + 8 * j; const LAS float* s = scr + (8 * c) * 65 + n;
        u32x4 o; o.x = cvt_pk_bf16(s[0 * 65], s[1 * 65]); o.y = cvt_pk_bf16(s[2 * 65], s[3 * 65]); o.z = cvt_pk_bf16(s[4 * 65], s[5 * 65]); o.w = cvt_pk_bf16(s[6 * 65], s[7 * 65]);
        st16(WT + (size_t)(dr0 + n) * K + k0 + 8 * c, o); }
    asm volatile("s_waitcnt lgkmcnt(0)" ::: "memory");
}
__device__ __forceinline__ void norm_phase(const CBuf& cb, const float* X, const float* g, const float* msc, const float* msh, bf16_t* U, int gw, int NGW, int lane) {
    for (int m0 = gw; m0 < MTOK; m0 += 4 * NGW) {
        f32x4 v[4][4];
#pragma unroll
        for (int r = 0; r < 4; ++r) { const f32x4* xr = (const f32x4*)(X + (size_t)(m0 + r * NGW) * DM) + lane;
#pragma unroll
            for (int j = 0; j < 4; ++j) v[r][j] = ld16bf(cb, xr + 64 * j); }
#pragma unroll
        for (int r = 0; r < 4; ++r) { const int m = m0 + r * NGW, b = m >> 11; float s = 0.f;
#pragma unroll
            for (int j = 0; j < 4; ++j) s += (v[r][j][0] * v[r][j][0] + v[r][j][1] * v[r][j][1]) + (v[r][j][2] * v[r][j][2] + v[r][j][3] * v[r][j][3]);
            const float rstd = rsqrtf(wave_sum(s) * (1.f / DM) + EPS);
#pragma unroll
            for (int j = 0; j < 4; ++j) { const int c = 4 * lane + 256 * j;
                const f32x4 gg = *(const f32x4*)(g + c), sc = *(const f32x4*)(msc + (size_t)b * MODW + c), sh = *(const f32x4*)(msh + (size_t)b * MODW + c);
                const f32x4 y = v[r][j] * rstd * gg * (sc + 1.0f) + sh; u32x2 w; w.x = cvt_pk_bf16(y[0], y[1]); w.y = cvt_pk_bf16(y[2], y[3]);
                st8(U + (size_t)m * DM + c, w); } }
    }
}


#define LDS_BARRIER() asm volatile("s_waitcnt lgkmcnt(0)\n\ts_barrier" ::: "memory")
constexpr int AT_BUF = 71680, AT_KS = 0, AT_VT = 36864, AT_FK = 70656, AT_VS = 528;
__device__ __forceinline__ void attn_unit(const CBuf& cb, LAS unsigned char* lds, int b, int h, int qb, bf16_t* QF, const bf16_t* KF, const bf16_t* VTF, const float* FC, const float* qg, const float* kg) {
    int tid = threadIdx.x; asm volatile("" : "+v"(tid));
    const int lane = tid & 63, w = __builtin_amdgcn_readfirstlane(tid >> 6), l31 = lane & 31, hh = lane >> 5;
    const int q0 = qb * 256, qrow = q0 + 32 * w + l31; const size_t grow = (size_t)b * SEQ + qrow;
    const float* FCs = FC + ((size_t)b * 16 + h) * SEQ;
    const int krow0 = tid >> 3, kch = tid & 7;
    const bf16_t* ksrc = KF + ((size_t)b * SEQ + krow0) * DM + h * 64 + 8 * kch;
    const bf16_t* vsrc = VTF + (size_t)(h * 64) * MTOK + (size_t)b * SEQ;
    f32x4 kg0 = *(const f32x4*)(kg + h * 64 + 8 * kch), kg1 = *(const f32x4*)(kg + h * 64 + 8 * kch + 4);
    u32x4 kraw[4], vraw[4]; float fraw = 0.f;
#define AT_LOAD(st_) do { const int kv0_ = 256 * (st_); \
        _Pragma("unroll") for (int i = 0; i < 4; ++i) { kraw[i] = ld16b(cb, ksrc + (size_t)(kv0_ + 64 * i) * DM); \
            const int idx = tid + 512 * i, d = idx >> 5, ch = idx & 31; vraw[i] = ld16b(cb, vsrc + (size_t)d * MTOK + kv0_ + 8 * ch); } \
        if (tid < 256) fraw = ld4c(FCs + kv0_ + tid); } while (0)
    AT_LOAD(qb);
    bf16x8 qfrag[4];
    {
        const bf16_t* qp = QF + grow * DM + h * 64 + 8 * hh; u32x4 raw[4]; float ss = 0.f;
#pragma unroll
        for (int ks = 0; ks < 4; ++ks) raw[ks] = ld16b(cb, qp + 16 * ks);
#pragma unroll
        for (int ks = 0; ks < 4; ++ks)
#pragma unroll
            for (int i = 0; i < 4; ++i) { const float lo = bflo(raw[ks][i]), hi = bfhi(raw[ks][i]); ss += lo * lo + hi * hi; }
        ss += __shfl_xor(ss, 32);
        const float rs = rsqrtf(ss * (1.f / 64.f) + EPS) * (0.125f * LOG2E);
#pragma unroll
        for (int ks = 0; ks < 4; ++ks) { const float* gp = qg + h * 64 + 16 * ks + 8 * hh; const f32x4 g0 = *(const f32x4*)gp, g1 = *(const f32x4*)(gp + 4);
            u32x4 pk;
            pk.x = cvt_pk_bf16(bflo(raw[ks][0]) * rs * g0[0], bfhi(raw[ks][0]) * rs * g0[1]); pk.y = cvt_pk_bf16(bflo(raw[ks][1]) * rs * g0[2], bfhi(raw[ks][1]) * rs * g0[3]);
            pk.z = cvt_pk_bf16(bflo(raw[ks][2]) * rs * g1[0], bfhi(raw[ks][2]) * rs * g1[1]); pk.w = cvt_pk_bf16(bflo(raw[ks][3]) * rs * g1[2], bfhi(raw[ks][3]) * rs * g1[3]);
            qfrag[ks] = __builtin_bit_cast(bf16x8, pk); }
    }
    const float Fq = ld4c(FCs + qrow);
    float m_run = 0.f, l_run = 0.f; bool first = true; f32x16 oT[2], cinit;
#pragma unroll
    for (int r = 0; r < 16; ++r) { oT[0][r] = 0.f; oT[1][r] = 0.f; cinit[r] = Fq; }
    for (int it = 0; it <= qb; ++it) {
        const int st = qb - it;
        LAS unsigned char* B = lds + (it & 1) * AT_BUF;
#pragma unroll
        for (int i = 0; i < 4; ++i) {
            float kv[8]; float ss = 0.f;
#pragma unroll
            for (int j = 0; j < 4; ++j) { kv[2 * j] = bflo(kraw[i][j]); kv[2 * j + 1] = bfhi(kraw[i][j]); ss += kv[2 * j] * kv[2 * j] + kv[2 * j + 1] * kv[2 * j + 1]; }
            ss += __shfl_xor(ss, 1); ss += __shfl_xor(ss, 2); ss += __shfl_xor(ss, 4);
            const float rs = rsqrtf(ss * (1.f / 64.f) + EPS);
#pragma unroll
            for (int j = 0; j < 4; ++j) { kv[j] *= rs * kg0[j]; kv[4 + j] *= rs * kg1[j]; }
            *(LAS u32x4*)(B + AT_KS + (krow0 + 64 * i) * 144 + kch * 16) = pack8(kv);
            const int idx = tid + 512 * i, d = idx >> 5, ch = idx & 31;
            *(LAS u32x4*)(B + AT_VT + d * AT_VS + ch * 16) = vraw[i];
        }
        if (tid < 256) *(LAS float*)(B + AT_FK + tid * 4) = fraw;
        LDS_BARRIER();
        if (st > 0) AT_LOAD(st - 1);
        for (int sub = 3; sub >= 0; --sub) {
            const int kt = 4 * st + sub;
            if (64 * kt > q0 + 32 * w + 31) continue;
            const LAS unsigned char* Bk = B + AT_KS + (64 * sub) * 144;
            const LAS unsigned char* Bv = B + AT_VT + (64 * sub) * 2;
            const LAS unsigned char* Bf = B + AT_FK + (64 * sub) * 4;
            bf16x8 kf[2][4]; f32x4 fkv[2][4];
#pragma unroll
            for (int kb = 0; kb < 2; ++kb)
#pragma unroll
                for (int ks = 0; ks < 4; ++ks) kf[kb][ks] = *(const LAS bf16x8*)(Bk + (32 * kb + l31) * 144 + ks * 32 + hh * 16);
            f32x16 sT[2];
#pragma unroll
            for (int kb = 0; kb < 2; ++kb) { f32x16 acc = mfma32(kf[kb][0], qfrag[0], cinit);
#pragma unroll
                for (int ks = 1; ks < 4; ++ks) acc = mfma32(kf[kb][ks], qfrag[ks], acc);
                sT[kb] = acc; }
#pragma unroll
            for (int kb = 0; kb < 2; ++kb)
#pragma unroll
                for (int g = 0; g < 4; ++g) fkv[kb][g] = *(const LAS f32x4*)(Bf + (32 * kb + 8 * g + 4 * hh) * 4);
            u32x2 vlo[2][2][2], vhi[2][2][2];
#pragma unroll
            for (int kb = 0; kb < 2; ++kb)
#pragma unroll
                for (int s = 0; s < 2; ++s)
#pragma unroll
                    for (int db = 0; db < 2; ++db) { const LAS unsigned char* vp = Bv + (32 * db + l31) * AT_VS + (32 * kb + 16 * s + 4 * hh) * 2;
                        vlo[kb][s][db] = *(const LAS u32x2*)vp; vhi[kb][s][db] = *(const LAS u32x2*)(vp + 16); }
#pragma unroll
            for (int kb = 0; kb < 2; ++kb)
#pragma unroll
                for (int g = 0; g < 4; ++g)
#pragma unroll
                    for (int i = 0; i < 4; ++i) sT[kb][4 * g + i] -= fkv[kb][g][i];
            if (64 * kt + 63 > q0 + 32 * w) {
#pragma unroll
                for (int kb = 0; kb < 2; ++kb)
#pragma unroll
                    for (int r = 0; r < 16; ++r) { const int kvi = 64 * kt + 32 * kb + (r & 3) + 8 * (r >> 2) + 4 * hh; if (kvi > qrow) sT[kb][r] = -INFINITY; }
            }
#define MX3(a_, b_, c_) __builtin_fmaxf(__builtin_fmaxf((a_), (b_)), (c_))
            float mxa = MX3(sT[0][0], sT[0][1], sT[0][2]), mxb = MX3(sT[1][0], sT[1][1], sT[1][2]);
#pragma unroll
            for (int r = 3; r < 15; r += 2) { mxa = MX3(mxa, sT[0][r], sT[0][r + 1]); mxb = MX3(mxb, sT[1][r], sT[1][r + 1]); }
            float mx = MX3(mxa, mxb, __builtin_fmaxf(sT[0][15], sT[1][15]));
#undef MX3
            { const auto rr = __builtin_amdgcn_permlane32_swap(__float_as_uint(mx), __float_as_uint(mx), false, false); mx = fmaxf(__uint_as_float(rr[0]), __uint_as_float(rr[1])); }
            if (first || __builtin_amdgcn_ballot_w64(mx > 0.f) != 0ull) {
                const float dl = first ? mx : fmaxf(mx, 0.f), alpha = first ? 1.f : __builtin_amdgcn_exp2f(-dl);
                m_run += dl; l_run *= alpha; first = false;
#pragma unroll
                for (int r = 0; r < 16; ++r) { oT[0][r] *= alpha; oT[1][r] *= alpha; sT[0][r] -= dl; sT[1][r] -= dl; cinit[r] = Fq - m_run; }
            }
            float ps = 0.f;
#pragma unroll
            for (int kb = 0; kb < 2; ++kb)
#pragma unroll
                for (int r = 0; r < 16; ++r) { const float p = __builtin_amdgcn_exp2f(sT[kb][r]); sT[kb][r] = p; ps += p; }
            { const auto rr = __builtin_amdgcn_permlane32_swap(__float_as_uint(ps), __float_as_uint(ps), false, false); ps = __uint_as_float(rr[0]) + __uint_as_float(rr[1]); }
            l_run += ps;
#pragma unroll
            for (int kb = 0; kb < 2; ++kb)
#pragma unroll
                for (int s = 0; s < 2; ++s) { u32x4 pk; pk.x = cvt_pk_bf16(sT[kb][8 * s + 0], sT[kb][8 * s + 1]); pk.y = cvt_pk_bf16(sT[kb][8 * s + 2], sT[kb][8 * s + 3]);
                    pk.z = cvt_pk_bf16(sT[kb][8 * s + 4], sT[kb][8 * s + 5]); pk.w = cvt_pk_bf16(sT[kb][8 * s + 6], sT[kb][8 * s + 7]);
                    const bf16x8 pf = __builtin_bit_cast(bf16x8, pk);
#pragma unroll
                    for (int db = 0; db < 2; ++db) { u32x4 av; av.x = vlo[kb][s][db].x; av.y = vlo[kb][s][db].y; av.z = vhi[kb][s][db].x; av.w = vhi[kb][s][db].y;
                        oT[db] = mfma32(__builtin_bit_cast(bf16x8, av), pf, oT[db]); } }
        }
    }
#undef AT_LOAD
    {
        const float inv = 1.0f / l_run; bf16_t* op = QF + grow * DM + h * 64;
#pragma unroll
        for (int db = 0; db < 2; ++db)
#pragma unroll
            for (int g = 0; g < 4; ++g) { u32x2 o; o.x = cvt_pk_bf16(oT[db][4 * g] * inv, oT[db][4 * g + 1] * inv); o.y = cvt_pk_bf16(oT[db][4 * g + 2] * inv, oT[db][4 * g + 3] * inv);
                st8(op + 32 * db + 8 * g + 4 * hh, o); }
    }
    LDS_BARRIER();
}

constexpr int ML_QS = 0, ML_KS = 17408, ML_KWT = 34816, ML_VT = 53248, ML_SP = 90112, ML_HST = 99328, ML_FV = 133120;
__device__ __forceinline__ void mlstm_item(const CBuf& cb, LAS unsigned char* lds, int item, unsigned char* wsb, const bf16_t* QKM, const bf16_t* VTM, bf16_t* OM, const float* GATES, const float* convw, const float* convb, const float* normg) {
    const int b = item >> 2, h = item & 3;
    const int tid0 = threadIdx.x, w = __builtin_amdgcn_readfirstlane(tid0 >> 6);
    LAS float* fv = (LAS float*)(lds + ML_FV);
    LAS float* bvec = fv, *avec = fv + 64, *mtv = fv + 128, *winter = fv + 192, *qn = fv + 320, *rowsum = fv + 384, *emt = fv + 448, *nvec = fv + 512, *scal = fv + 640;
    LAS float* mprev = (LAS float*)(lds + ML_FV + 4096), *mnew = mprev + 32, *blastv = mprev + 64, *mxwv = mprev + 96;
    float* GV = (float*)(wsb + WS_GV) + (size_t)item * (32 * 256);
    f32x16 Cacc[4];
#pragma unroll
    for (int d = 0; d < 4; ++d)
#pragma unroll
        for (int r = 0; r < 16; ++r) Cacc[d][r] = 0.f;
    if (tid0 < 128) nvec[tid0] = 0.f;
    {
        int tid = tid0; asm volatile("" : "+v"(tid)); const int lane = tid & 63;
#pragma unroll
        for (int ci = 0; ci < 4; ++ci) { const int c = w + 8 * ci; const size_t tn = (size_t)b * SEQ + 64 * c;
            const float ig = ld4c(GATES + (tn + lane) * 32 + h), fg = ld4c(GATES + (tn + lane) * 32 + 4 + h);
            float bs = logsig_f(fg);
#pragma unroll
            for (int o = 1; o < 64; o <<= 1) { const float t = __shfl_up(bs, o); if (lane >= o) bs += t; }
            const float a = ig - bs; float cm = a;
#pragma unroll
            for (int o = 1; o < 64; o <<= 1) { const float t = __shfl_up(cm, o); if (lane >= o) cm = fmaxf(cm, t); }
            const float blast = __shfl(bs, 63);
            float mxw = blast - bs + ig;
#pragma unroll
            for (int o = 1; o < 64; o <<= 1) mxw = fmaxf(mxw, __shfl_xor(mxw, o));
            float* g = GV + c * 256 + lane;
            __hip_atomic_store((unsigned*)(g), __float_as_uint(bs), __ATOMIC_RELAXED, __HIP_MEMORY_SCOPE_AGENT);
            __hip_atomic_store((unsigned*)(g + 64), __float_as_uint(a), __ATOMIC_RELAXED, __HIP_MEMORY_SCOPE_AGENT);
            __hip_atomic_store((unsigned*)(g + 128), __float_as_uint(cm), __ATOMIC_RELAXED, __HIP_MEMORY_SCOPE_AGENT);
            __hip_atomic_store((unsigned*)(g + 192), __float_as_uint(ig), __ATOMIC_RELAXED, __HIP_MEMORY_SCOPE_AGENT);
            if (lane == 0) { blastv[c] = blast; mxwv[c] = mxw; } }
        asm volatile("s_waitcnt vmcnt(0)" ::: "memory");
        __syncthreads();
        if (tid < 64) { float m = 0.f;
            float mp_keep = 0.f, mn_keep = 0.f;
#pragma unroll 1
            for (int c = 0; c < 32; ++c) { const float mn = fmaxf(blastv[c] + m, mxwv[c]); if (lane == c) { mp_keep = m; mn_keep = mn; } m = mn; }
            if (lane < 32) { mprev[lane] = mp_keep; mnew[lane] = mn_keep; } }
        __syncthreads();
    }
    u32x4 raw[7], vt[4]; f32x4 bs4 = (f32x4){0.f, 0.f, 0.f, 0.f}, ig4 = bs4; float gbs = 0.f, ga = 0.f, gcm = 0.f;
#define ML_IDX const int lane = tid & 63, l31 = lane & 31, hh = lane >> 5, fr = lane & 15, fq = lane >> 4; \
        const int cc = tid & 31, rg = tid >> 5; const bool isk = cc >= 16; const int chl = isk ? 512 + h * 128 + 8 * (cc - 16) : h * 128 + 8 * cc; \
        (void)l31; (void)hh; (void)fr; (void)fq;
#define ML_LOAD(cn) do { const size_t tn = (size_t)b * SEQ + 64 * (cn); \
        _Pragma("unroll") for (int jr = 0; jr < 7; ++jr) { const int tl = 4 * rg - 3 + jr; if ((cn) > 0 || tl >= 0) raw[jr] = ld16b(cb, QKM + (size_t)((long)tn + tl) * DM + chl); else raw[jr] = (u32x4){0u, 0u, 0u, 0u}; } \
        _Pragma("unroll") for (int i = 0; i < 4; ++i) { const int idx = tid + 512 * i, e = idx >> 3, ch = idx & 7; vt[i] = ld16b(cb, VTM + (size_t)(h * 256 + e) * MTOK + tn + 8 * ch); } \
        if (isk) { bs4 = ld16bf(cb, GV + (cn) * 256 + 4 * rg); ig4 = ld16bf(cb, GV + (cn) * 256 + 192 + 4 * rg); } \
        if (w == 0) { gbs = ld4c(GV + (cn) * 256 + lane); ga = ld4c(GV + (cn) * 256 + 64 + lane); gcm = ld4c(GV + (cn) * 256 + 128 + lane); } } while (0)
#define ML_OMLOAD(cprev) do { const size_t tp = (size_t)b * SEQ + 64 * (cprev); \
        _Pragma("unroll") for (int rr = 0; rr < 8; ++rr) om[rr] = ld8c(OM + (tp + 8 * w + rr) * DM + h * 256 + 4 * lane); \
        gnorm = *(const f32x4*)(normg + h * 256 + 4 * lane); } while (0)
#define ML_STEP5(cprev) do { const size_t tp = (size_t)b * SEQ + 64 * (cprev); \
        _Pragma("unroll") for (int rr = 0; rr < 8; ++rr) { const int t = 8 * w + rr; const u32x2 hv = *(const LAS u32x2*)(lds + ML_HST + t * 528 + lane * 8); \
            const float h0 = bflo(hv.x), h1 = bfhi(hv.x), h2 = bflo(hv.y), h3 = bfhi(hv.y); \
            const float rstd = rsqrtf(wave_sum((h0 * h0 + h1 * h1) + (h2 * h2 + h3 * h3)) * (1.f / 256.f) + EPS); \
            bf16_t* op = OM + (tp + t) * DM + h * 256 + 4 * lane; const u32x2 ov = om[rr]; const f32x4 g = gnorm; \
            u32x2 o; o.x = cvt_pk_bf16(sigmoid_f(bflo(ov.x)) * h0 * rstd * g[0], sigmoid_f(bfhi(ov.x)) * h1 * rstd * g[1]); \
            o.y = cvt_pk_bf16(sigmoid_f(bflo(ov.y)) * h2 * rstd * g[2], sigmoid_f(bfhi(ov.y)) * h3 * rstd * g[3]); \
            st8(op, o); } } while (0)
    u32x2 om[8]; f32x4 gnorm;
    { int tid = tid0; asm volatile("" : "+v"(tid)); ML_IDX; ML_LOAD(0); }
    for (int c = 0; c < 32; ++c) {
        int tid = tid0; asm volatile("" : "+v"(tid));
        ML_IDX;
        const float mp = mprev[c], mn = mnew[c], bl = blastv[c];
        if (w == 0) {
            const float mt_ = fmaxf(gbs + mp, gbs + gcm);
            bvec[lane] = gbs; avec[lane] = ga; mtv[lane] = mt_; winter[lane] = expf(gbs + mp - mt_); emt[lane] = expf(-mt_);
            if (lane == 0) scal[0] = expf(bl + mp - mn);
        }
        {
            const float* cwp = convw; const float* cbp = convb;
            f32x4 cw[4][2], cbv[2];
#pragma unroll
            for (int j = 0; j < 4; ++j) { cw[j][0] = *(const f32x4*)(cwp + j * 1024 + chl); cw[j][1] = *(const f32x4*)(cwp + j * 1024 + chl + 4); }
            cbv[0] = *(const f32x4*)(cbp + chl); cbv[1] = *(const f32x4*)(cbp + chl + 4);
            float outv[4][8];
#pragma unroll
            for (int i = 0; i < 8; ++i) {
                float x[7];
#pragma unroll
                for (int jr = 0; jr < 7; ++jr) x[jr] = (i & 1) ? bfhi(raw[jr][i >> 1]) : bflo(raw[jr][i >> 1]);
#pragma unroll
                for (int o = 0; o < 4; ++o) { float v = cbv[i >> 2][i & 3];
#pragma unroll
                    for (int j = 0; j < 4; ++j) v += cw[j][i >> 2][i & 3] * x[o + j];
                    v = v * __builtin_amdgcn_rcpf(1.f + __expf(-v)); outv[o][i] = isk ? v * 0.08838834764831845f : v; }
            }
            if (!isk) {
#pragma unroll
                for (int o = 0; o < 4; ++o) *(LAS u32x4*)(lds + ML_QS + (4 * rg + o) * 272 + cc * 16) = pack8(outv[o]);
            } else {
#pragma unroll
                for (int o = 0; o < 4; ++o) *(LAS u32x4*)(lds + ML_KS + (4 * rg + o) * 272 + (cc - 16) * 16) = pack8(outv[o]);
                f32x4 wk4;
#pragma unroll
                for (int j = 0; j < 4; ++j) wk4[j] = expf(bl - bs4[j] + ig4[j] - mn);
#pragma unroll
                for (int i = 0; i < 8; ++i) { u32x2 p; p.x = cvt_pk_bf16(outv[0][i] * wk4[0], outv[1][i] * wk4[1]); p.y = cvt_pk_bf16(outv[2][i] * wk4[2], outv[3][i] * wk4[3]);
                    *(LAS u32x2*)(lds + ML_KWT + (8 * (cc - 16) + i) * 144 + rg * 8) = p; }
            }
#pragma unroll
            for (int i = 0; i < 4; ++i) { const int idx = tid + 512 * i, e = idx >> 3, ch = idx & 7; *(LAS u32x4*)(lds + ML_VT + e * 144 + ch * 16) = vt[i]; }
            if (tid < 64) rowsum[tid] = 0.f;
        }
        if (c + 1 < 32) ML_LOAD(c + 1);
        if (c > 0) ML_STEP5(c - 1);
        LDS_BARRIER();
        {
            const int rb = w >> 1;
#pragma unroll
            for (int ci = 0; ci < 2; ++ci) { const int cb = 2 * (w & 1) + ci;
                if (cb <= rb) {
                    f32x4 acc = (f32x4){0.f, 0.f, 0.f, 0.f};
#pragma unroll
                    for (int ks = 0; ks < 4; ++ks) { const bf16x8 a = *(const LAS bf16x8*)(lds + ML_QS + (16 * rb + fr) * 272 + (32 * ks + 8 * fq) * 2);
                        const bf16x8 bb = *(const LAS bf16x8*)(lds + ML_KS + (16 * cb + fr) * 272 + (32 * ks + 8 * fq) * 2); acc = mfma16(a, bb, acc); }
                    const int s = 16 * cb + fr; const float as = avec[s];
#pragma unroll
                    for (int j = 0; j < 4; ++j) { const int t = 16 * rb + 4 * fq + j; float v = (s <= t) ? acc[j] * __expf(bvec[t] + as - mtv[t]) : 0.f;
                        *(LAS bf16_t*)(lds + ML_SP + t * 144 + s * 2) = (bf16_t)(cvt_pk_bf16(v, 0.f) & 0xffffu);
                        v += __shfl_xor(v, 1); v += __shfl_xor(v, 2); v += __shfl_xor(v, 4); v += __shfl_xor(v, 8);
                        if (fr == 0) __hip_atomic_fetch_add(rowsum + t, v, __ATOMIC_RELAXED, __HIP_MEMORY_SCOPE_WORKGROUP); }
                } else {
#pragma unroll
                    for (int j = 0; j < 4; ++j) *(LAS bf16_t*)(lds + ML_SP + (16 * rb + 4 * fq + j) * 144 + (16 * cb + fr) * 2) = (bf16_t)0;
                }
            }
            const int t = tid >> 3, part = tid & 7;
            const u32x4 qa = *(const LAS u32x4*)(lds + ML_QS + t * 272 + part * 32), qb2 = *(const LAS u32x4*)(lds + ML_QS + t * 272 + part * 32 + 16);
            float s = 0.f;
#pragma unroll
            for (int i = 0; i < 4; ++i) { s += bflo(qa[i]) * nvec[16 * part + 2 * i] + bfhi(qa[i]) * nvec[16 * part + 2 * i + 1]; s += bflo(qb2[i]) * nvec[16 * part + 8 + 2 * i] + bfhi(qb2[i]) * nvec[16 * part + 8 + 2 * i + 1]; }
            s += __shfl_xor(s, 1); s += __shfl_xor(s, 2); s += __shfl_xor(s, 4);
            if (part == 0) qn[t] = s;
        }
        LDS_BARRIER();
        ML_OMLOAD(c);
        {
            const float decay = scal[0];
            bf16x8 bv[4];
#pragma unroll
            for (int ks = 0; ks < 4; ++ks) bv[ks] = *(const LAS bf16x8*)(lds + ML_VT + (32 * w + l31) * 144 + (16 * ks + 8 * hh) * 2);
            f32x16 num[2];
#pragma unroll
            for (int r = 0; r < 16; ++r) { num[0][r] = 0.f; num[1][r] = 0.f; }
#pragma unroll
            for (int db = 0; db < 4; ++db)
#pragma unroll
                for (int s = 0; s < 2; ++s) { u32x4 pk; pk.x = cvt_pk_bf16(Cacc[db][8 * s + 0], Cacc[db][8 * s + 1]); pk.y = cvt_pk_bf16(Cacc[db][8 * s + 2], Cacc[db][8 * s + 3]);
                    pk.z = cvt_pk_bf16(Cacc[db][8 * s + 4], Cacc[db][8 * s + 5]); pk.w = cvt_pk_bf16(Cacc[db][8 * s + 6], Cacc[db][8 * s + 7]); const bf16x8 cf = __builtin_bit_cast(bf16x8, pk);
#pragma unroll
                    for (int tb = 0; tb < 2; ++tb) { const LAS unsigned char* qp = lds + ML_QS + (32 * tb + l31) * 272 + (32 * db + 16 * s + 4 * hh) * 2;
                        const u32x2 lo = *(const LAS u32x2*)qp, hi = *(const LAS u32x2*)(qp + 16); u32x4 av; av.x = lo.x; av.y = lo.y; av.z = hi.x; av.w = hi.y;
                        num[tb] = mfma32(__builtin_bit_cast(bf16x8, av), cf, num[tb]); } }
#pragma unroll
            for (int tb = 0; tb < 2; ++tb) {
                f32x16 acc = num[tb];
#pragma unroll
                for (int g = 0; g < 4; ++g) { const f32x4 wi = *(const LAS f32x4*)(winter + 32 * tb + 8 * g + 4 * hh);
#pragma unroll
                    for (int i = 0; i < 4; ++i) acc[4 * g + i] *= wi[i]; }
#pragma unroll
                for (int ks = 0; ks < 4; ++ks) { const bf16x8 a = *(const LAS bf16x8*)(lds + ML_SP + (32 * tb + l31) * 144 + (16 * ks + 8 * hh) * 2); acc = mfma32(a, bv[ks], acc); }
#pragma unroll
                for (int g = 0; g < 4; ++g) { const int r0 = 32 * tb + 8 * g + 4 * hh;
                    const f32x4 wi = *(const LAS f32x4*)(winter + r0), q4 = *(const LAS f32x4*)(qn + r0), rs4 = *(const LAS f32x4*)(rowsum + r0), em4 = *(const LAS f32x4*)(emt + r0);
#pragma unroll
                    for (int i = 0; i < 4; ++i) { const float den = wi[i] * q4[i] + rs4[i]; const float dn = fmaxf(fabsf(den), em4[i]); const float hv = acc[4 * g + i] * __builtin_amdgcn_rcpf(dn);
                        *(LAS bf16_t*)(lds + ML_HST + (r0 + i) * 528 + (32 * w + l31) * 2) = (bf16_t)(cvt_pk_bf16(hv, 0.f) & 0xffffu); } }
            }
#pragma unroll
            for (int db = 0; db < 4; ++db) {
#pragma unroll
                for (int r = 0; r < 16; ++r) Cacc[db][r] *= decay;
#pragma unroll
                for (int ks = 0; ks < 4; ++ks) { const bf16x8 a = *(const LAS bf16x8*)(lds + ML_KWT + (32 * db + l31) * 144 + (16 * ks + 8 * hh) * 2); Cacc[db] = mfma32(a, bv[ks], Cacc[db]); }
            }
            const int d = tid >> 2, part = tid & 3;
            const u32x4 ka = *(const LAS u32x4*)(lds + ML_KWT + d * 144 + part * 32), kb2 = *(const LAS u32x4*)(lds + ML_KWT + d * 144 + part * 32 + 16);
            float s = 0.f;
#pragma unroll
            for (int i = 0; i < 4; ++i) s += (bflo(ka[i]) + bfhi(ka[i])) + (bflo(kb2[i]) + bfhi(kb2[i]));
            s += __shfl_xor(s, 1); s += __shfl_xor(s, 2);
            if (part == 0) nvec[d] = decay * nvec[d] + s;
        }
        LDS_BARRIER();
    }
    { int tid = tid0; asm volatile("" : "+v"(tid)); const int lane = tid & 63; ML_STEP5(31); }
    __syncthreads();
#undef ML_IDX
#undef ML_LOAD
#undef ML_STEP5
#undef ML_OMLOAD
}


#define XB_TMO      128
#define XB_XCNT(j)  (256  + 64 * (j))
#define XB_XSUB(j)  (1280 + 64 * (j))
#define XB_XGEN(j)  (2304 + 64 * (j))
#define XB_TOP      3328
#define XB_TOPGEN   3392
#define XCD_BAR_WORDS 3456
#define XB_SPIN_CAP (1u << 18)

__device__ __forceinline__ unsigned xb_ld(unsigned* p)              { return __hip_atomic_load(p, __ATOMIC_RELAXED, __HIP_MEMORY_SCOPE_AGENT); }
__device__ __forceinline__ unsigned xb_add(unsigned* p, unsigned v) { return __hip_atomic_fetch_add(p, v, __ATOMIC_RELAXED, __HIP_MEMORY_SCOPE_AGENT); }
__device__ __forceinline__ unsigned xb_xcc_id() { return (unsigned)__builtin_amdgcn_s_getreg((3 << 11) | 20) & 0xFu; }
#define XB_SPIN(cond, bar) do { unsigned _sp = 0; while (cond) { __builtin_amdgcn_s_sleep(1); \
    if ((++_sp & 255u) == 0u) { if (xb_ld(&(bar)[XB_TMO])) break; if (_sp > XB_SPIN_CAP) { atomicAdd(&(bar)[XB_TMO], 1u); break; } } } } while (0)

struct XcdBarrier {
    unsigned* bar; unsigned x;
    volatile LAS unsigned* st;
};

__device__ __forceinline__ XcdBarrier xcd_barrier_post(unsigned* bar, volatile LAS unsigned* st) {
    XcdBarrier b; b.bar = bar; b.x = xb_xcc_id(); b.st = st;
    if (threadIdx.x == 0) (void)xb_add(&bar[XB_XCNT(b.x)], 1u);
    return b;
}
__device__ __forceinline__ void xcd_barrier_complete(unsigned* bar, unsigned x, unsigned& nloc, unsigned& nx) {
    const unsigned G = gridDim.x * gridDim.y * gridDim.z;
    unsigned sum, cnt, mine, sp = 0u;
    for (;;) {
        sum = 0u; cnt = 0u; mine = 0u;
#pragma unroll
        for (unsigned j = 0; j < 16; ++j) { const unsigned c = xb_ld(&bar[XB_XCNT(j)]); sum += c; cnt += (c > 0u) ? 1u : 0u; mine = (j == x) ? c : mine; }
        if (sum == G) break;
        __builtin_amdgcn_s_sleep(1);
        if ((++sp & 255u) == 0u) { if (xb_ld(&bar[XB_TMO])) break; if (sp > XB_SPIN_CAP) { atomicAdd(&bar[XB_TMO], 1u); break; } }
    }
    nloc = mine > 0u ? mine : 1u; nx = cnt > 0u ? cnt : 1u;
}

__device__ __forceinline__ void xcd_barrier(const XcdBarrier& b) {
    asm volatile("s_waitcnt vmcnt(0)" ::: "memory");
    __syncthreads();
    if (threadIdx.x == 0) {
        unsigned* bar = b.bar;
        __builtin_amdgcn_s_waitcnt(0);
        unsigned nloc = b.st[0], nx = b.st[1];
        if (nloc == 0u) { xcd_barrier_complete(bar, b.x, nloc, nx); b.st[0] = nloc; b.st[1] = nx; }
        const unsigned old = xb_add(&bar[XB_XSUB(b.x)], 1u);
        const unsigned gen = old / nloc;
        if (old + 1u == (gen + 1u) * nloc) {
            __builtin_amdgcn_fence(__ATOMIC_RELEASE, "agent");
            asm volatile("s_waitcnt vmcnt(0)" ::: "memory");
            const unsigned og = xb_add(&bar[XB_TOP], 1u);
            const unsigned tg = og / nx;
            if (og + 1u == (tg + 1u) * nx) xb_add(&bar[XB_TOPGEN], 1u);
            else XB_SPIN(xb_ld(&bar[XB_TOPGEN]) == tg, bar);
            __builtin_amdgcn_fence(__ATOMIC_ACQUIRE, "agent");
            xb_add(&bar[XB_XGEN(b.x)], 1u);
            asm volatile("s_waitcnt vmcnt(0)" ::: "memory");
        } else {
            XB_SPIN(xb_ld(&bar[XB_XGEN(b.x)]) == gen, bar);
            __builtin_amdgcn_fence(__ATOMIC_ACQUIRE, "agent");
            asm volatile("s_waitcnt vmcnt(0)" ::: "memory");
        }
    }
    __syncthreads();
}

struct Args { const float* in[21]; float* out; unsigned char* ws; int nsteps, pad0; unsigned char sched[48]; };
constexpr int N_PHASES = 15;
__global__ void __launch_bounds__(512) fwd(Args a) {
    extern __shared__ __attribute__((aligned(16))) unsigned char lds_[];
    LAS unsigned char* lds = (LAS unsigned char*)lds_;
    cg::grid_group grid = cg::this_grid();
    const int G = gridDim.x, NGW = G * 8;
    unsigned char* ws = a.ws;
    const float* x = a.in[0]; float* out = a.out;
    float* mod = (float*)(ws + WS_MOD);
    bf16_t* U = (bf16_t*)(ws + WS_U); bf16_t* HID = (bf16_t*)(ws + WS_HID);
    const float* bmix = a.in[9];
    volatile LAS unsigned* MISC = (volatile LAS unsigned*)(lds + LDS_ITEM + 64);
    if (threadIdx.x < 16) MISC[threadIdx.x] = 0u;
    __syncthreads();
    XcdBarrier bar = xcd_barrier_post((unsigned*)(ws + WS_CNT) + 4096, MISC);
    if (a.nsteps > 1) grid.sync();
#define IN(k) (ph == (k))
#define SEAM(k) do { } while (0)
#ifndef MK_SC1A
#define MK_SC1A false
#endif
#define RUN_GEMM(EPI, E, Aop, Bop, Mr, Nr, Kr) RUN_GEMM_X(EPI, E, Aop, Bop, Mr, Nr, Kr, MK_SC1A, false)
#define RUN_GEMM_X(EPI, E, Aop, Bop, Mr, Nr, Kr, CA, CB) do { pg8::Gemm g_{(const bf16_t*)(Aop), (const bf16_t*)(Bop), (Mr), (Nr), (Kr)}; pg8::StaticOrder S_; S_.init((Mr), (Nr), G, (int)blockIdx.x); \
        pg8::gemm_phase<EPI, pg8::StaticOrder, false, true, CA, CB>(lds, g_, S_, E); } while (0)
#define RUN_GEMM_L(EPI, E, Aop, Bop, Mr, Nr, Kr, CA, CB) do { pg8::Gemm g_{(const bf16_t*)(Aop), (const bf16_t*)(Bop), (Mr), (Nr), (Kr)}; pg8::StaticOrder S_; S_.init((Mr), (Nr), G, (int)blockIdx.x); \
        pg8::gemm_phase<EPI, pg8::StaticOrder, false, true, CA, CB>(lds, g_, S_, E); } while (0)

    int n7 = 0;
    const CBuf cbw = make_cbuf(ws, (unsigned)WS_NEED), cbo = make_cbuf(out, (unsigned)((size_t)MTOK * DM * 4)), cbx = make_cbuf(x, (unsigned)((size_t)MTOK * DM * 4));
    for (int step = 0; step < a.nsteps; ++step) {
    const int ph = a.sched[step];
    int tid = threadIdx.x; asm volatile("" : "+v"(tid));
    const int lane = tid & 63, w = __builtin_amdgcn_readfirstlane(tid >> 6), gw = blockIdx.x * 8 + w;
    if (IN(0)) {
        if (blockIdx.x < 144) {
            LAS float* sc = (LAS float*)lds; const float* cin = a.in[1];
            for (int i = tid; i < 16384; i += 512) { const float v = cin[i]; sc[i] = v / (1.f + expf(-v)); }
            __syncthreads();
            const int n = blockIdx.x * 64 + lane, k0 = w * 128; const float* wada = a.in[2];
            float acc[16];
#pragma unroll
            for (int bb = 0; bb < 16; ++bb) acc[bb] = 0.f;
#pragma unroll 16
            for (int k = 0; k < 128; ++k) { const float wv = wada[(size_t)(k0 + k) * MODW + n];
#pragma unroll
                for (int bb = 0; bb < 16; ++bb) acc[bb] += sc[bb * 1024 + k0 + k] * wv; }
            LAS float* red = (LAS float*)(lds + 65536);
#pragma unroll
            for (int bb = 0; bb < 16; ++bb) red[(w * 16 + bb) * 64 + lane] = acc[bb];
            __syncthreads();
            for (int i = tid; i < 1024; i += 512) { const int bb = i >> 6, l = i & 63; float s = a.in[3][blockIdx.x * 64 + l];
#pragma unroll
                for (int ww = 0; ww < 8; ++ww) s += red[(ww * 16 + bb) * 64 + l];
                __hip_atomic_store((unsigned*)(mod + (size_t)bb * MODW + blockIdx.x * 64 + l), __float_as_uint(s), __ATOMIC_RELAXED, __HIP_MEMORY_SCOPE_AGENT); }
            __syncthreads();
        }
        {
            LAS float* scr = (LAS float*)(lds + w * 16640);
            constexpr int I_FI = 16 * 88, I_FO = 44 * 16, I_Z = 16 * 64, I_V = 16 * 32, I_G = 16 * 32, I_S = 16 * 16;
            constexpr int NITEMS = 2 * (I_FI + I_FO) + I_Z + I_V + I_G + 3 * I_S;
            for (int it = gw; it < NITEMS; it += NGW) {
                int r = it;
                if (r < 2 * (I_FI + I_FO)) {
                    const int which = r >= (I_FI + I_FO); if (which) r -= (I_FI + I_FO);
                    if (r < I_FI) { const int kb = r / 88, g = r % 88, p = g >> 2, half = (g >> 1) & 1, jj = g & 1;
                        tr_item(a.in[which ? 19 : 5], 1024, 5632, half * 2816 + 128 * p + 64 * jj, 64 * kb, (bf16_t*)(ws + (which ? WS_BT2I : WS_BT1I)), 64 * g, scr, lane); }
                    else { r -= I_FI; const int kb = r / 16, g = r % 16; tr_item(a.in[which ? 20 : 6], 2816, 1024, 64 * g, 64 * kb, (bf16_t*)(ws + (which ? WS_BT2O : WS_BT1O)), 64 * g, scr, lane); }
                    continue;
                }
                r -= 2 * (I_FI + I_FO);
                if (r < I_Z) { const int kb = r / 64, g = r % 64, dr0 = 64 * g; const int sc0 = dr0 < 1024 ? dr0 : dr0 < 2048 ? 2048 + (dr0 - 1024) : dr0 < 3072 ? 3080 + (dr0 - 2048) : 4104 + (dr0 - 3072);
                    tr_item(a.in[8], 1024, MIXW, sc0, 64 * kb, (bf16_t*)(ws + WS_BTZ), dr0, scr, lane); continue; }
                r -= I_Z;
                if (r < I_V) { const int kb = r / 32, g = r % 32, dr0 = 64 * g; const int sc0 = dr0 < 1024 ? 1024 + dr0 : 5128 + (dr0 - 1024);
                    tr_item(a.in[8], 1024, MIXW, sc0, 64 * kb, (bf16_t*)(ws + WS_WVT), dr0, scr, lane); continue; }
                r -= I_V;
                if (r < I_G) { const int kb = r / 32, g = r % 32, dr0 = 64 * g; tr_item(a.in[8], 1024, MIXW, 6168 + dr0, 64 * kb, (bf16_t*)(ws + WS_BTG), dr0, scr, lane); continue; }
                r -= I_G;
                { const int which = r / I_S; r %= I_S; const int kb = r / 16, g = r % 16;
                  tr_item(a.in[15 + which], 1024, 1024, 64 * g, 64 * kb, (bf16_t*)(ws + (which == 0 ? WS_BTA : which == 1 ? WS_BTB : WS_BTO)), 64 * g, scr, lane); }
            }
            bf16_t* BTZ = (bf16_t*)(ws + WS_BTZ); const float* wmix = a.in[8];
            for (int i = blockIdx.x * 512 + tid; i < 256 * 128; i += G * 512) { const int rr = i >> 7, k0 = (i & 127) * 8; const int col = rr < 8 ? 3072 + rr : rr < 24 ? 6152 + (rr - 8) : -1;
                float v[8];
#pragma unroll
                for (int j = 0; j < 8; ++j) v[j] = col >= 0 ? wmix[(size_t)(k0 + j) * MIXW + col] : 0.f;
                st16(BTZ + (size_t)(4096 + rr) * 1024 + k0, pack8(v)); }
        }
    }
    SEAM(0);
    if (IN(1)) norm_phase(cbx, x, a.in[4], mod + 1 * 1024, mod + 0 * 1024, U, gw, NGW, lane);
    SEAM(1);
    if (IN(2)) { EpiSwiglu E{HID}; RUN_GEMM(EpiSwiglu, E, U, ws + WS_BT1I, MTOK, 5632, 1024); }
    SEAM(2);
    if (IN(3)) { EpiRes E{x, out, mod + 2 * 1024, 0.5f, cbo, false}; RUN_GEMM_L(EpiRes, E, HID, ws + WS_BT1O, MTOK, 1024, 2816, MK_SC1A, false); }
    SEAM(3);
    if (IN(4)) norm_phase(cbo, out, a.in[7], mod + 4 * 1024, mod + 3 * 1024, U, gw, NGW, lane);
    SEAM(4);
    if (IN(5)) {
        { EpiZ E{ws, bmix}; RUN_GEMM(EpiZ, E, U, ws + WS_BTZ, MTOK, 4352, 1024); }
        { EpiVT E{ws, bmix}; RUN_GEMM_X(EpiVT, E, ws + WS_WVT, U, 2048, MTOK, 1024, false, MK_SC1A); }
    }
    SEAM(5);
    if (IN(6)) {
        const float* GT = (const float*)(ws + WS_GATES); float* FC = (float*)(ws + WS_FC);
        for (int seq = gw; seq < 256; seq += NGW) { const int bb = seq >> 4, h_ = seq & 15; float v[32]; float s = 0.f;
#pragma unroll
            for (int i = 0; i < 32; ++i) { const float f = ld4c(GT + ((size_t)bb * SEQ + 32 * lane + i) * 32 + 8 + h_); s += logsig_f(f); v[i] = s; }
            float inc = s;
#pragma unroll
            for (int o = 1; o < 64; o <<= 1) { const float t = __shfl_up(inc, o); if (lane >= o) inc += t; }
            const float exc = inc - s;
#pragma unroll
            for (int i = 0; i < 32; i += 4) st16f(FC + (size_t)seq * SEQ + 32 * lane + i, (f32x4){(v[i] + exc) * LOG2E, (v[i + 1] + exc) * LOG2E, (v[i + 2] + exc) * LOG2E, (v[i + 3] + exc) * LOG2E});
        }
    }
    SEAM(6);
    if (IN(7) || IN(15) || IN(16)) {
        unsigned* cnt = (unsigned*)(ws + WS_CNT) + 64 * n7; ++n7; LAS int* s_item = (LAS int*)(lds + LDS_ITEM);
        const int item_lo = IN(15) ? 64 : 0, item_hi = IN(16) ? 64 : 64 + 2048;
        for (;;) {
            if (tid == 0) *s_item = item_lo + (int)atomicAdd(cnt, 1u);
            __syncthreads();
            const int item = *s_item;
            __syncthreads();
            if (item >= item_hi) break;
            if (item < 64) mlstm_item(cbw, lds, item, ws, (const bf16_t*)(ws + WS_QKM), (const bf16_t*)(ws + WS_VTM), (bf16_t*)(ws + WS_OM), (const float*)(ws + WS_GATES), a.in[10], a.in[11], a.in[12]);
            else { const int idx = item - 64, bh = idx & 255, qb = 7 - (idx >> 8);
                attn_unit(cbw, lds, bh >> 4, bh & 15, qb, (bf16_t*)(ws + WS_QF), (const bf16_t*)(ws + WS_KF), (const bf16_t*)(ws + WS_VTF), (const float*)(ws + WS_FC), a.in[13], a.in[14]); }
        }
    }
    SEAM(7);
    if (IN(8)) { EpiSig E{(bf16_t*)(ws + WS_SG), bmix}; RUN_GEMM(EpiSig, E, U, ws + WS_BTG, MTOK, 2048, 1024); }
    SEAM(8);
    if (IN(9)) { EpiMul E{(const bf16_t*)(ws + WS_SG), (bf16_t*)(ws + WS_T)}; RUN_GEMM_L(EpiMul, E, ws + WS_OM, ws + WS_BTA, MTOK, 1024, 1024, MK_SC1A, false); }
    SEAM(9);
    if (IN(9) || IN(10)) { EpiMerge E{(const bf16_t*)(ws + WS_SG), (const bf16_t*)(ws + WS_T), (bf16_t*)(ws + WS_MRG), cbw}; RUN_GEMM_L(EpiMerge, E, ws + WS_QF, ws + WS_BTB, MTOK, 1024, 1024, MK_SC1A, false); }
    SEAM(10);
    if (IN(11)) { EpiRes E{out, out, mod + 5 * 1024, 1.0f, cbo, true}; RUN_GEMM_L(EpiRes, E, ws + WS_MRG, ws + WS_BTO, MTOK, 1024, 1024, MK_SC1A, false); }
    SEAM(11);
    if (IN(12)) norm_phase(cbo, out, a.in[18], mod + 7 * 1024, mod + 6 * 1024, (bf16_t*)(ws + WS_QF), gw, NGW, lane);
    SEAM(12);
    if (IN(13)) { EpiSwiglu E{HID}; RUN_GEMM(EpiSwiglu, E, ws + WS_QF, ws + WS_BT2I, MTOK, 5632, 1024); }
    SEAM(13);
    if (IN(14)) { EpiRes E{out, out, mod + 8 * 1024, 0.5f, cbo, true}; RUN_GEMM_L(EpiRes, E, HID, ws + WS_BT2O, MTOK, 1024, 2816, MK_SC1A, false); }

    if (step + 1 < a.nsteps) xcd_barrier(bar);
    }
#undef IN
#undef SEAM
#undef RUN_GEMM
#undef RUN_GEMM_X
}

extern "C" void kernel_launch(void* const* d_in, const int* in_sizes, int n_in, void* d_out, int out_size, void* d_ws, size_t ws_size, hipStream_t stream) {
    static int grid = 0;
    if (grid == 0) {
        if (n_in != 21 || out_size != MTOK * DM || ws_size < WS_NEED) { fprintf(stderr, "kernel_launch: unexpected sizes n_in %d out %d ws %zu\n", n_in, out_size, ws_size); grid = -1; return; }
        int dev = 0, cus = 0, per_cu = 0;
        hipGetDevice(&dev); hipDeviceGetAttribute(&cus, hipDeviceAttributeMultiprocessorCount, dev);
        hipFuncSetAttribute((const void*)fwd, hipFuncAttributeMaxDynamicSharedMemorySize, LDS_BYTES);
        hipOccupancyMaxActiveBlocksPerMultiprocessor(&per_cu, (const void*)fwd, 512, LDS_BYTES);
        (void)hipGetLastError();
        if (per_cu < 1) per_cu = 1;
        grid = cus * per_cu;
        fprintf(stderr, "kernel_launch: cus %d per_cu %d grid %d ws %zu\n", cus, per_cu, grid, ws_size);
    }
    if (grid < 0) return;
    hipMemsetAsync((char*)d_ws + WS_CNT, 0, 65536, stream);
    Args a{};
    for (int i = 0; i < 21; ++i) a.in[i] = (const float*)d_in[i];
    a.out = (float*)d_out; a.ws = (unsigned char*)d_ws;
#if MK_SINGLE
#ifndef MK_SCHED
#define MK_SCHED {0,1,2,3,4,5,6,7,8,9,11,12,13,14}
#endif
    { const unsigned char sc[] = MK_SCHED; a.nsteps = (int)sizeof(sc); for (int i = 0; i < a.nsteps; ++i) a.sched[i] = sc[i]; }
    void* args[] = {&a};
    hipError_t e = hipLaunchCooperativeKernel((const void*)fwd, dim3(grid), dim3(512), args, LDS_BYTES, stream);
    if (e != hipSuccess) fprintf(stderr, "cooperative launch failed: %s (grid %d)\n", hipGetErrorString(e), grid);
#endif
}
```

```cpp
#include <hip/hip_runtime.h>
#include <hip/hip_cooperative_groups.h>
#include <cstdio>
#include <cstdint>
namespace cg = cooperative_groups;
namespace pg8 {
#define PG8_LAS __attribute__((address_space(3)))
typedef unsigned short bf16_t;
typedef short bf16x8 __attribute__((ext_vector_type(8)));
typedef float f32x4 __attribute__((ext_vector_type(4)));
typedef unsigned u32x4 __attribute__((ext_vector_type(4)));
constexpr int BM = 256, BK = 64, HALF = 128, HTB = HALF * BK * 2  , STAGE_BYTES = 8 * HTB, NXCD = 8, WGM = 4;

__host__ __device__ __forceinline__ int lds_byte(int r, int c) { const int st = (r >> 4) * 2 + (c >> 5), rr = r & 15, cc = c & 31, ob = rr * 64 + cc * 2; return st * 1024 + (ob ^ (((ob >> 9) & 1) << 5)); }
__host__ __device__ __forceinline__ void stage_rc(int b, int& R, int& C) { const int st = b / 1024, sb = b % 1024, swz = sb ^ (((sb >> 9) & 1) << 5); R = (st >> 1) * 16 + swz / 64; C = (st & 1) * 32 + (swz % 64) / 2; }
__host__ __device__ __forceinline__ int perm32(int rho) { const int n = rho >> 4, i = rho & 15; return 8 * (i >> 2) + 4 * n + (i & 3); }

struct Unit { int pm, pn; };
struct Gemm { const bf16_t* A; const bf16_t* Bt; int M, N, K; };

struct StaticOrder {
    int nM, nN, nwg, G, c;
    __host__ __device__ void init(int M, int N, int G_, int c_) { nM = M / BM; nN = N / BM; nwg = nM * nN; G = G_; c = c_; }
    __host__ __device__ bool next(int i, Unit& u) const {
        const long L = (long)i * G + c; if (L >= nwg) return false;
        int wgid = (int)L; { const int q = nwg / NXCD, r = nwg % NXCD, xcd = wgid % NXCD, off = wgid / NXCD; wgid = (xcd < r ? xcd * (q + 1) : r * (q + 1) + (xcd - r) * q) + off; }
        const int nig = WGM * nN, gid = wgid / nig, fm = gid * WGM, gsz = (nM - fm) < WGM ? (nM - fm) : WGM;
        u.pm = fm + ((wgid % nig) % gsz); u.pn = (wgid % nig) / gsz; return true;
    }
    __device__ __forceinline__ void a_ready(const Unit&) const {}
    __device__ __forceinline__ void done(const Unit&) const {}
};
typedef float cvt_f32x2_t __attribute__((ext_vector_type(2))); typedef __bf16 cvt_bf16x2_t __attribute__((ext_vector_type(2)));
__device__ __forceinline__ unsigned cvt_pk_bf16(float lo, float hi) { const cvt_f32x2_t v = {lo, hi}; const cvt_bf16x2_t b = __builtin_convertvector(v, cvt_bf16x2_t); return __builtin_bit_cast(unsigned, b); }
typedef float f32x2 __attribute__((ext_vector_type(2)));
template <class Epi, class Sched, bool ALIGN_EPI = false, bool SP2 = false, bool SC1A = false, bool SC1B = false>
__device__ __forceinline__ void gemm_phase(PG8_LAS unsigned char* lds, const Gemm g, const Sched& S, const Epi& E) {
    int tid = threadIdx.x; asm volatile("" : "+v"(tid)); const int wid = __builtin_amdgcn_readfirstlane(tid >> 6), lane = tid & 63, wr = wid >> 2, wc = wid & 3, fr = lane & 15, fq = lane >> 4;
    const int K = g.K, nt = K / BK;
    unsigned voffA[2], voffB[2];
#pragma unroll
    for (int i = 0; i < 2; ++i) { int R, C; stage_rc(tid * 16 + i * 8192, R, C); const int Rb = Epi::PERM ? ((R & ~31) + perm32(R & 31)) : R;
        voffA[i] = (unsigned)(R * K + C) * 2u; voffB[i] = (unsigned)(Rb * K + C) * 2u; }
    const size_t kstep = (size_t)(BK * 2);
    const size_t hstep = (size_t)HALF * K * 2;
    const size_t tstep = 2 * hstep;
    const unsigned ldsw = (unsigned)wid * 1024u;
    const int aoff = lds_byte(wr * 64 + fr, fq * 8), boff = lds_byte(wc * 32 + fr, fq * 8);
#define PG8_SA(b, h) (((b) * 2 + (h)) * HTB)
#define PG8_SB(b, h) ((4 + (b) * 2 + (h)) * HTB)
#define PG8_STAGE_X(bufoff, gbase, voff, AUX) do { _Pragma("unroll") for (int _i = 0; _i < 2; ++_i) \
        __builtin_amdgcn_global_load_lds((const unsigned*)((const char*)(gbase) + (voff)[_i]), (PG8_LAS unsigned*)(lds + (bufoff) + ldsw + _i * 8192), 16, 0, AUX); } while (0)
#define PG8_STAGE_A(bufoff, gbase, voff) do { if constexpr (SC1A) PG8_STAGE_X(bufoff, gbase, voff, 16); else PG8_STAGE_X(bufoff, gbase, voff, 0); } while (0)
#define PG8_STAGE_B(bufoff, gbase, voff) do { if constexpr (SC1B) PG8_STAGE_X(bufoff, gbase, voff, 16); else PG8_STAGE_X(bufoff, gbase, voff, 0); } while (0)
#define PG8_LDA(dst, b, h) do { _Pragma("unroll") for (int m = 0; m < 4; ++m) _Pragma("unroll") for (int k = 0; k < 2; ++k) dst[m][k] = *(const PG8_LAS bf16x8*)(lds + PG8_SA(b, h) + aoff + m * 2048 + k * 1024); } while (0)
#define PG8_LDB(dst, b, h) do { _Pragma("unroll") for (int n = 0; n < 2; ++n) _Pragma("unroll") for (int k = 0; k < 2; ++k) dst[n][k] = *(const PG8_LAS bf16x8*)(lds + PG8_SB(b, h) + boff + n * 2048 + k * 1024); } while (0)
#define PG8_MMA(ai, bj, At, Bt) do { __builtin_amdgcn_s_setprio(1); _Pragma("unroll") for (int m = 0; m < 4; ++m) _Pragma("unroll") for (int n = 0; n < 2; ++n) _Pragma("unroll") for (int k = 0; k < 2; ++k) \
        acc[ai][bj][m][n] = __builtin_amdgcn_mfma_f32_16x16x32_bf16(Bt[n][k], At[m][k], acc[ai][bj][m][n], 0, 0, 0); __builtin_amdgcn_s_setprio(0); } while (0)
#define PG8_WAIT_V(n) asm volatile("s_waitcnt vmcnt(" #n ")" ::: "memory")
#define PG8_WAIT_L(n) asm volatile("s_waitcnt lgkmcnt(" #n ")" ::: "memory")
#define PG8_BAR __builtin_amdgcn_s_barrier()
#define PG8_SCHED __builtin_amdgcn_sched_barrier(0)
    Unit cur, nxt; int ui = 0;
    if (!S.next(0, cur)) return;
    f32x4 acc[2][2][4][2];
#pragma unroll
    for (int a = 0; a < 2; ++a)
#pragma unroll
        for (int b = 0; b < 2; ++b)
#pragma unroll
            for (int m = 0; m < 4; ++m)
#pragma unroll
                for (int n = 0; n < 2; ++n) acc[a][b][m][n] = (f32x4){0.f, 0.f, 0.f, 0.f};
    bf16x8 At[4][2], B0[2][2], B1[2][2];
    const char* cA = (const char*)g.A + (size_t)cur.pm * tstep; const char* cB = (const char*)g.Bt + (size_t)cur.pn * tstep;
    S.a_ready(cur);
    if constexpr (SP2) {
        PG8_STAGE_B(PG8_SB(0, 0), cB, voffB); PG8_STAGE_B(PG8_SB(0, 1), cB + hstep, voffB); PG8_STAGE_A(PG8_SA(0, 0), cA, voffA); PG8_STAGE_A(PG8_SA(0, 1), cA + hstep, voffA);
        if (wr == 1) PG8_BAR;
        PG8_WAIT_V(2); PG8_BAR;
        PG8_STAGE_B(PG8_SB(1, 0), cB + kstep, voffB); PG8_STAGE_A(PG8_SA(1, 0), cA + kstep, voffA); PG8_STAGE_B(PG8_SB(1, 1), cB + hstep + kstep, voffB);
        PG8_WAIT_V(6); PG8_BAR;
    } else {
        PG8_STAGE_B(PG8_SB(0, 0), cB, voffB); PG8_STAGE_A(PG8_SA(0, 0), cA, voffA); PG8_STAGE_B(PG8_SB(0, 1), cB + hstep, voffB); PG8_STAGE_A(PG8_SA(0, 1), cA + hstep, voffA);
        if (wr == 1) PG8_BAR;
        PG8_WAIT_V(4); PG8_BAR;
        PG8_STAGE_B(PG8_SB(1, 0), cB + kstep, voffB); PG8_STAGE_A(PG8_SA(1, 0), cA + kstep, voffA); PG8_STAGE_B(PG8_SB(1, 1), cB + hstep + kstep, voffB);
        PG8_WAIT_V(6); PG8_BAR;
    }
    for (;;) {
        const bool has_next = S.next(ui + 1, nxt);
        const char* nA = has_next ? (const char*)g.A + (size_t)nxt.pm * tstep : cA; const char* nB = has_next ? (const char*)g.Bt + (size_t)nxt.pn * tstep : cB;
        for (int t = 0; t < nt; t += 2) {
            const bool last = (t == nt - 2);
            const char* a1 = cA + (size_t)(t + 1) * kstep;
            const char* a2 = last ? nA : cA + (size_t)(t + 2) * kstep; const char* b2 = last ? nB : cB + (size_t)(t + 2) * kstep;
            const char* a3 = a2 + kstep; const char* b3 = b2 + kstep;
            if (last && has_next) S.a_ready(nxt);
            if constexpr (SP2) {
            PG8_LDB(B0, 0, 0); PG8_LDB(B1, 0, 1); PG8_SCHED; PG8_LDA(At, 0, 0); PG8_STAGE_A(PG8_SA(1, 1), a1 + hstep, voffA);
            PG8_WAIT_V(8); PG8_WAIT_L(0); PG8_BAR; PG8_MMA(0, 0, At, B0); PG8_MMA(0, 1, At, B1); PG8_BAR; PG8_SCHED;
            PG8_LDA(At, 0, 1); PG8_STAGE_B(PG8_SB(0, 0), b2, voffB); PG8_STAGE_B(PG8_SB(0, 1), b2 + hstep, voffB); PG8_STAGE_A(PG8_SA(0, 0), a2, voffA);
            PG8_WAIT_V(8); PG8_WAIT_L(0); PG8_BAR; PG8_MMA(1, 0, At, B0); PG8_MMA(1, 1, At, B1); PG8_BAR; PG8_SCHED;
            PG8_LDB(B0, 1, 0); PG8_LDB(B1, 1, 1); PG8_SCHED; PG8_LDA(At, 1, 0); PG8_STAGE_A(PG8_SA(0, 1), a2 + hstep, voffA);
            PG8_WAIT_V(8); PG8_WAIT_L(0); PG8_BAR; PG8_MMA(0, 0, At, B0); PG8_MMA(0, 1, At, B1); PG8_BAR; PG8_SCHED;
            PG8_LDA(At, 1, 1); PG8_STAGE_B(PG8_SB(1, 0), b3, voffB); PG8_STAGE_B(PG8_SB(1, 1), b3 + hstep, voffB); PG8_STAGE_A(PG8_SA(1, 0), a3, voffA);
            PG8_WAIT_V(8); PG8_WAIT_L(0); PG8_BAR; PG8_MMA(1, 0, At, B0); PG8_MMA(1, 1, At, B1); PG8_BAR; PG8_SCHED;
            } else {
            PG8_LDB(B0, 0, 0); PG8_SCHED; PG8_LDA(At, 0, 0); PG8_STAGE_A(PG8_SA(1, 1), a1 + hstep, voffA);
            PG8_WAIT_L(8); PG8_BAR; PG8_WAIT_L(0); PG8_MMA(0, 0, At, B0); PG8_BAR; PG8_SCHED;
            PG8_LDB(B1, 0, 1); PG8_STAGE_B(PG8_SB(0, 0), b2, voffB);
            PG8_BAR; PG8_WAIT_L(0); PG8_MMA(0, 1, At, B1); PG8_BAR;
            PG8_LDA(At, 0, 1); PG8_STAGE_A(PG8_SA(0, 0), a2, voffA);
            PG8_BAR; PG8_WAIT_L(0); PG8_MMA(1, 0, At, B0); PG8_BAR; PG8_SCHED;
            PG8_STAGE_B(PG8_SB(0, 1), b2 + hstep, voffB);
            PG8_WAIT_V(6); PG8_BAR; PG8_MMA(1, 1, At, B1); PG8_BAR;
            PG8_LDB(B0, 1, 0); PG8_SCHED; PG8_LDA(At, 1, 0); PG8_STAGE_A(PG8_SA(0, 1), a2 + hstep, voffA);
            PG8_WAIT_L(8); PG8_BAR; PG8_WAIT_L(0); PG8_MMA(0, 0, At, B0); PG8_BAR; PG8_SCHED;
            PG8_LDB(B1, 1, 1); PG8_STAGE_B(PG8_SB(1, 0), b3, voffB);
            PG8_BAR; PG8_WAIT_L(0); PG8_MMA(0, 1, At, B1); PG8_BAR;
            PG8_LDA(At, 1, 1); PG8_STAGE_A(PG8_SA(1, 0), a3, voffA);
            PG8_BAR; PG8_WAIT_L(0); PG8_MMA(1, 0, At, B0); PG8_BAR; PG8_SCHED;
            PG8_STAGE_B(PG8_SB(1, 1), b3 + hstep, voffB);
            PG8_WAIT_V(6); PG8_BAR; PG8_MMA(1, 1, At, B1); PG8_BAR;
            }
        }
        if constexpr (ALIGN_EPI) { if (wr == 0) PG8_BAR; }
        if constexpr (!Epi::AFTER_DRAIN) { E(acc, cur, wr, wc, fr, fq); S.done(cur); }
        if (!has_next) break;
#pragma unroll
        for (int a = 0; a < 2; ++a)
#pragma unroll
            for (int b = 0; b < 2; ++b)
#pragma unroll
                for (int m = 0; m < 4; ++m)
#pragma unroll
                    for (int n = 0; n < 2; ++n) acc[a][b][m][n] = (f32x4){0.f, 0.f, 0.f, 0.f};
        cur = nxt; cA = nA; cB = nB; ++ui;
        if constexpr (ALIGN_EPI) { if (wr == 1) PG8_BAR; }
    }
    PG8_WAIT_V(0);
    if constexpr (!ALIGN_EPI) { if (wr == 0) PG8_BAR; }
    PG8_BAR;
    if constexpr (Epi::AFTER_DRAIN) { E.fused(acc, cur, wr, wc, fr, fq, lds, wid, lane); S.done(cur); }
#undef PG8_SA
#undef PG8_SB
#undef PG8_STAGE_X
#undef PG8_STAGE_A
#undef PG8_STAGE_B
#undef PG8_LDA
#undef PG8_LDB
#undef PG8_MMA
#undef PG8_WAIT_V
#undef PG8_WAIT_L
#undef PG8_BAR
#undef PG8_SCHED
}
}

#ifndef MK_SINGLE
#define MK_SINGLE 1
#endif
#define LAS __attribute__((address_space(3)))
using pg8::bf16_t; using pg8::bf16x8; using pg8::f32x4; using pg8::cvt_pk_bf16;
typedef float f32x16 __attribute__((ext_vector_type(16)));
typedef unsigned u32x4 __attribute__((ext_vector_type(4)));
typedef unsigned u32x2 __attribute__((ext_vector_type(2)));
constexpr int NB = 16, SEQ = 2048, DM = 1024, MTOK = NB * SEQ, DFF = 2816, MIXW = 8216, MODW = 9216;
constexpr float EPS = 1e-6f, LOG2E = 1.4426950408889634f;
constexpr size_t MiB = 1u << 20;
constexpr size_t WS_MOD = 0, WS_CNT = 1 * MiB, WS_GATES = 2 * MiB, WS_FC = 6 * MiB,
    WS_BTZ = 8 * MiB, WS_WVT = 17 * MiB, WS_BTG = 21 * MiB, WS_BTA = 25 * MiB, WS_BTB = 27 * MiB, WS_BTO = 29 * MiB, WS_BT2I = 31 * MiB, WS_BT2O = 42 * MiB,
    WS_U = 48 * MiB, WS_QKM = 112 * MiB, WS_VTM = 176 * MiB, WS_OM = 240 * MiB, WS_QF = 304 * MiB, WS_KF = 368 * MiB, WS_VTF = 432 * MiB, WS_END = 496 * MiB,
    WS_HID = 112 * MiB, WS_BT1I = 288 * MiB, WS_BT1O = 299 * MiB, WS_T = 112 * MiB, WS_SG = 368 * MiB, WS_MRG = 48 * MiB, WS_GV = 496 * MiB, WS_NEED = 498 * MiB;
constexpr int LDS_BYTES = 147456, LDS_ITEM = 143360;

__device__ __forceinline__ float bflo(unsigned u) { return __uint_as_float(u << 16); }
__device__ __forceinline__ float bfhi(unsigned u) { return __uint_as_float(u & 0xffff0000u); }
__device__ __forceinline__ float sigmoid_f(float v) { return __builtin_amdgcn_rcpf(1.f + __expf(-v)); }
__device__ __forceinline__ float silu_f(float v) { return v * sigmoid_f(v); }
__device__ __forceinline__ float logsig_f(float f) { return fminf(f, 0.f) - log1pf(expf(-fabsf(f))); }
__device__ __forceinline__ float wave_sum(float v) {
#pragma unroll
    for (int o = 1; o < 64; o <<= 1) v += __shfl_xor(v, o);
    return v;
}
__device__ __forceinline__ u32x4 pack8(const float* v) { u32x4 w; w.x = cvt_pk_bf16(v[0], v[1]); w.y = cvt_pk_bf16(v[2], v[3]); w.z = cvt_pk_bf16(v[4], v[5]); w.w = cvt_pk_bf16(v[6], v[7]); return w; }
__device__ __forceinline__ f32x16 mfma32(bf16x8 a, bf16x8 b, f32x16 c) { return __builtin_amdgcn_mfma_f32_32x32x16_bf16(a, b, c, 0, 0, 0); }
__device__ __forceinline__ f32x4 mfma16(bf16x8 a, bf16x8 b, f32x4 c) { return __builtin_amdgcn_mfma_f32_16x16x32_bf16(a, b, c, 0, 0, 0); }


__device__ __forceinline__ void st16(void* p, u32x4 v) { asm volatile("global_store_dwordx4 %0, %1, off sc1\n\ts_nop 1" :: "v"(p), "v"(v)); }
__device__ __forceinline__ void st16f(void* p, f32x4 v) { asm volatile("global_store_dwordx4 %0, %1, off sc1\n\ts_nop 1" :: "v"(p), "v"(v)); }
__device__ __forceinline__ void st8(void* p, u32x2 v) { asm volatile("global_store_dwordx2 %0, %1, off sc1\n\ts_nop 1" :: "v"(p), "v"(v)); }

__device__ __forceinline__ u32x2 ld8c(const void* p) { const unsigned long long v = __hip_atomic_load((const unsigned long long*)p, __ATOMIC_RELAXED, __HIP_MEMORY_SCOPE_AGENT); u32x2 r; r.x = (unsigned)v; r.y = (unsigned)(v >> 32); return r; }
__device__ __forceinline__ u32x4 ld16c(const void* p) { const u32x2 a = ld8c(p), b = ld8c((const char*)p + 8); u32x4 r; r.x = a.x; r.y = a.y; r.z = b.x; r.w = b.y; return r; }
__device__ __forceinline__ f32x4 ld16cf(const void* p) { return __builtin_bit_cast(f32x4, ld16c(p)); }
__device__ __forceinline__ float ld4c(const float* p) { return __uint_as_float(__hip_atomic_load((const unsigned*)p, __ATOMIC_RELAXED, __HIP_MEMORY_SCOPE_AGENT)); }

struct CBuf { __amdgpu_buffer_rsrc_t rs; const unsigned char* base; };
__device__ __forceinline__ CBuf make_cbuf(const void* base, unsigned bytes) { CBuf c; c.rs = __builtin_amdgcn_make_buffer_rsrc((void*)base, (short)0, (int)bytes, 0x00020000); c.base = (const unsigned char*)base; return c; }
__device__ __forceinline__ u32x4 ld16b(const CBuf& c, const void* p) { return __builtin_amdgcn_raw_buffer_load_b128(c.rs, (unsigned)((const unsigned char*)p - c.base), 0, 16); }
__device__ __forceinline__ f32x4 ld16bf(const CBuf& c, const void* p) { return __builtin_bit_cast(f32x4, ld16b(c, p)); }
struct EpiSwiglu {
    static constexpr bool PERM = true, AFTER_DRAIN = false; bf16_t* O;
    __device__ __forceinline__ void operator()(const f32x4 (&acc)[2][2][4][2], const pg8::Unit& u, int wr, int wc, int fr, int fq) const {
        const int row0 = u.pm * 256 + wr * 64 + fr, col0 = u.pn * 128 + wc * 32 + 8 * fq;
#pragma unroll
        for (int ai = 0; ai < 2; ++ai)
#pragma unroll
            for (int m = 0; m < 4; ++m) {
                bf16_t* p = O + (size_t)(row0 + ai * 128 + m * 16) * DFF + col0;
                float hv[8];
#pragma unroll
                for (int n = 0; n < 2; ++n)
#pragma unroll
                    for (int j = 0; j < 4; ++j) hv[4 * n + j] = silu_f(acc[ai][0][m][n][j]) * acc[ai][1][m][n][j];
                st16(p, pack8(hv));
            }
    }
};
struct EpiRes {
    static constexpr bool PERM = false, AFTER_DRAIN = false; const float* base; float* out; const float* coef; float scale; CBuf cb; bool coh;
    __device__ __forceinline__ void operator()(const f32x4 (&acc)[2][2][4][2], const pg8::Unit& u, int wr, int wc, int fr, int fq) const {
        const int col0 = u.pn * 256 + wc * 32 + 4 * fq; const float* cf = coef + (size_t)(u.pm >> 3) * MODW;
        f32x4 g[2][2];
#pragma unroll
        for (int bj = 0; bj < 2; ++bj)
#pragma unroll
            for (int n = 0; n < 2; ++n) g[bj][n] = *(const f32x4*)(cf + col0 + bj * 128 + n * 16) * scale;
#pragma unroll
        for (int ai = 0; ai < 2; ++ai)
#pragma unroll
            for (int mp = 0; mp < 2; ++mp) {
                f32x4 bs[2][2][2];
#pragma unroll
                for (int mm = 0; mm < 2; ++mm) { const size_t off = (size_t)(u.pm * 256 + ai * 128 + wr * 64 + (2 * mp + mm) * 16 + fr) * DM + col0;
#pragma unroll
                    for (int bj = 0; bj < 2; ++bj)
#pragma unroll
                        for (int n = 0; n < 2; ++n) { const size_t o = off + bj * 128 + n * 16; bs[mm][bj][n] = coh ? ld16bf(cb, base + o) : *(const f32x4*)(base + o); } }
#pragma unroll
                for (int mm = 0; mm < 2; ++mm) { const size_t off = (size_t)(u.pm * 256 + ai * 128 + wr * 64 + (2 * mp + mm) * 16 + fr) * DM + col0;
#pragma unroll
                    for (int bj = 0; bj < 2; ++bj)
#pragma unroll
                        for (int n = 0; n < 2; ++n) st16f(out + off + bj * 128 + n * 16, bs[mm][bj][n] + g[bj][n] * acc[ai][bj][2 * mp + mm][n]); }
            }
    }
};
struct EpiZ {
    static constexpr bool PERM = true, AFTER_DRAIN = false; unsigned char* ws; const float* bmix;
    __device__ __forceinline__ void operator()(const f32x4 (&acc)[2][2][4][2], const pg8::Unit& u, int wr, int wc, int fr, int fq) const {
        const int pn = u.pn, rowb = u.pm * 256 + wr * 64 + fr;
        if (pn < 16) {
            const int seg = pn >> 2; bf16_t* base = (bf16_t*)(ws + (seg == 0 ? WS_QKM : WS_OM + (size_t)(seg - 1) * 64 * MiB));
            const int boff = seg == 0 ? 0 : seg == 1 ? 2048 : seg == 2 ? 3080 : 4104;
            const int col0 = (pn & 3) * 256 + wc * 32 + 8 * fq;
            f32x4 bv[2][2];
#pragma unroll
            for (int bj = 0; bj < 2; ++bj)
#pragma unroll
                for (int n = 0; n < 2; ++n) bv[bj][n] = *(const f32x4*)(bmix + boff + col0 + bj * 128 + 4 * n);
#pragma unroll
            for (int ai = 0; ai < 2; ++ai)
#pragma unroll
                for (int m = 0; m < 4; ++m) { bf16_t* rowp = base + (size_t)(rowb + ai * 128 + m * 16) * DM + col0;
#pragma unroll
                    for (int bj = 0; bj < 2; ++bj) { const f32x4 v0 = acc[ai][bj][m][0] + bv[bj][0], v1 = acc[ai][bj][m][1] + bv[bj][1];
                        u32x4 w; w.x = cvt_pk_bf16(v0[0], v0[1]); w.y = cvt_pk_bf16(v0[2], v0[3]); w.z = cvt_pk_bf16(v1[0], v1[1]); w.w = cvt_pk_bf16(v1[2], v1[3]);
                        st16(rowp + bj * 128, w); } }
        } else if (wc == 0) {
            float* G = (float*)(ws + WS_GATES);
#pragma unroll
            for (int n = 0; n < 2; ++n) { const int lc0 = 8 * fq + 4 * n;
                f32x4 bb = (f32x4){0.f, 0.f, 0.f, 0.f};
                if (lc0 < 8) bb = *(const f32x4*)(bmix + 3072 + lc0); else if (lc0 < 24) bb = *(const f32x4*)(bmix + 6152 + lc0 - 8);
#pragma unroll
                for (int ai = 0; ai < 2; ++ai)
#pragma unroll
                    for (int m = 0; m < 4; ++m) st16f(G + (size_t)(rowb + ai * 128 + m * 16) * 32 + lc0, acc[ai][0][m][n] + bb); }
        }
    }
};
struct EpiVT {
    static constexpr bool PERM = true, AFTER_DRAIN = false; unsigned char* ws; const float* bmix;
    __device__ __forceinline__ void operator()(const f32x4 (&acc)[2][2][4][2], const pg8::Unit& u, int wr, int wc, int fr, int fq) const {
        const bool isf = u.pm >= 4; bf16_t* base = (bf16_t*)(ws + (isf ? WS_VTF : WS_VTM)); const int boff = isf ? 5128 : 1024;
        const int rl0 = (u.pm & 3) * 256 + wr * 64 + fr, col0 = u.pn * 256 + wc * 32 + 8 * fq;
#pragma unroll
        for (int ai = 0; ai < 2; ++ai)
#pragma unroll
            for (int m = 0; m < 4; ++m) { const int rl = rl0 + ai * 128 + m * 16; const float bs = bmix[boff + rl]; bf16_t* rowp = base + (size_t)rl * MTOK + col0;
#pragma unroll
                for (int bj = 0; bj < 2; ++bj) { const f32x4 v0 = acc[ai][bj][m][0] + bs, v1 = acc[ai][bj][m][1] + bs;
                    u32x4 w; w.x = cvt_pk_bf16(v0[0], v0[1]); w.y = cvt_pk_bf16(v0[2], v0[3]); w.z = cvt_pk_bf16(v1[0], v1[1]); w.w = cvt_pk_bf16(v1[2], v1[3]);
                    st16(rowp + bj * 128, w); } }
    }
};
struct EpiSig {
    static constexpr bool PERM = true, AFTER_DRAIN = false; bf16_t* SG; const float* bmix;
    __device__ __forceinline__ void operator()(const f32x4 (&acc)[2][2][4][2], const pg8::Unit& u, int wr, int wc, int fr, int fq) const {
        const int rowb = u.pm * 256 + wr * 64 + fr, col0 = u.pn * 256 + wc * 32 + 8 * fq;
        f32x4 bv[2][2];
#pragma unroll
        for (int bj = 0; bj < 2; ++bj)
#pragma unroll
            for (int n = 0; n < 2; ++n) bv[bj][n] = *(const f32x4*)(bmix + 6168 + col0 + bj * 128 + 4 * n);
#pragma unroll
        for (int ai = 0; ai < 2; ++ai)
#pragma unroll
            for (int m = 0; m < 4; ++m) { bf16_t* rowp = SG + (size_t)(rowb + ai * 128 + m * 16) * 2048 + col0;
#pragma unroll
                for (int bj = 0; bj < 2; ++bj) { float hv[8];
#pragma unroll
                    for (int n = 0; n < 2; ++n)
#pragma unroll
                        for (int j = 0; j < 4; ++j) hv[4 * n + j] = sigmoid_f(acc[ai][bj][m][n][j] + bv[bj][n][j]);
                    st16(rowp + bj * 128, pack8(hv)); } }
    }
};
struct EpiMul {
    static constexpr bool PERM = false, AFTER_DRAIN = false; const bf16_t* SG; bf16_t* T;
    __device__ __forceinline__ void operator()(const f32x4 (&acc)[2][2][4][2], const pg8::Unit& u, int wr, int wc, int fr, int fq) const {
        const int col0 = u.pn * 256 + wc * 32 + 4 * fq;
#pragma unroll
        for (int ai = 0; ai < 2; ++ai) {
            u32x2 g[4][2][2];
#pragma unroll
            for (int m = 0; m < 4; ++m) { const size_t r = (size_t)(u.pm * 256 + ai * 128 + wr * 64 + m * 16 + fr);
#pragma unroll
                for (int bj = 0; bj < 2; ++bj)
#pragma unroll
                    for (int n = 0; n < 2; ++n) g[m][bj][n] = ld8c(SG + r * 2048 + col0 + bj * 128 + n * 16); }
#pragma unroll
            for (int m = 0; m < 4; ++m) { const size_t r = (size_t)(u.pm * 256 + ai * 128 + wr * 64 + m * 16 + fr);
#pragma unroll
                for (int bj = 0; bj < 2; ++bj)
#pragma unroll
                    for (int n = 0; n < 2; ++n) { const int c = col0 + bj * 128 + n * 16; const u32x2 gg = g[m][bj][n];
                        const f32x4 gv = (f32x4){bflo(gg.x), bfhi(gg.x), bflo(gg.y), bfhi(gg.y)}; const f32x4 tv = gv * acc[ai][bj][m][n];
                        u32x2 tw; tw.x = cvt_pk_bf16(tv[0], tv[1]); tw.y = cvt_pk_bf16(tv[2], tv[3]); st8(T + r * DM + c, tw); } }
        }
    }
};
struct EpiMerge {
    static constexpr bool PERM = false, AFTER_DRAIN = false; const bf16_t* SG; const bf16_t* T; bf16_t* O; CBuf cb;
    __device__ __forceinline__ void operator()(const f32x4 (&acc)[2][2][4][2], const pg8::Unit& u, int wr, int wc, int fr, int fq) const {
        const int col0 = u.pn * 256 + wc * 32 + 4 * fq;
#pragma unroll
        for (int ai = 0; ai < 2; ++ai) {
            u32x2 g[4][2][2], t[4][2][2];
#pragma unroll
            for (int m = 0; m < 4; ++m) { const size_t r = (size_t)(u.pm * 256 + ai * 128 + wr * 64 + m * 16 + fr);
#pragma unroll
                for (int bj = 0; bj < 2; ++bj)
#pragma unroll
                    for (int n = 0; n < 2; ++n) { const int c = col0 + bj * 128 + n * 16; g[m][bj][n] = ld8c(SG + r * 2048 + 1024 + c); t[m][bj][n] = ld8c(T + r * DM + c); } }
#pragma unroll
            for (int m = 0; m < 4; ++m) { const size_t r = (size_t)(u.pm * 256 + ai * 128 + wr * 64 + m * 16 + fr);
#pragma unroll
                for (int bj = 0; bj < 2; ++bj)
#pragma unroll
                    for (int n = 0; n < 2; ++n) { const int c = col0 + bj * 128 + n * 16; const u32x2 gg = g[m][bj][n], tq = t[m][bj][n];
                        const f32x4 gv = (f32x4){bflo(gg.x), bfhi(gg.x), bflo(gg.y), bfhi(gg.y)}, tv = (f32x4){bflo(tq.x), bfhi(tq.x), bflo(tq.y), bfhi(tq.y)};
                        const f32x4 v = tv + gv * acc[ai][bj][m][n]; u32x2 w; w.x = cvt_pk_bf16(v[0], v[1]); w.y = cvt_pk_bf16(v[2], v[3]); st8(O + r * DM + c, w); } }
        }
    }
};

__device__ __forceinline__ void tr_item(const float* W, int K, int N, int sc0, int k0, bf16_t* WT, int dr0, LAS float* scr, int lane) {
    f32x4 tv[16];
#pragma unroll
    for (int i = 0; i < 16; ++i) { const int kk = 4 * i + (lane >> 4); tv[i] = *(const f32x4*)(W + (size_t)(k0 + kk) * N + sc0 + 4 * (lane & 15)); }
#pragma unroll
    for (int i = 0; i < 16; ++i) { const int kk = 4 * i + (lane >> 4); LAS float* d = scr + kk * 65 + 4 * (lane & 15); d[0] = tv[i][0]; d[1] = tv[i][1]; d[2] = tv[i][2]; d[3] = tv[i][3]; }
    asm volatile("s_waitcnt lgkmcnt(0)" ::: "memory");
    const int c = lane & 7;
#pragma unroll
    for (int j = 0; j < 8; ++j) { const int n = (lane >> 3) + 8 * j; const LAS float* s = scr + (8 * c) * 65 + n;
        u32x4 o; o.x = cvt_pk_bf16(s[0 * 65], s[1 * 65]); o.y = cvt_pk_bf16(s[2 * 65], s[3 * 65]); o.z = cvt_pk_bf16(s[4 * 65], s[5 * 65]); o.w = cvt_pk_bf16(s[6 * 65], s[7 * 65]);
        st16(WT + (size_t)(dr0 + n) * K + k0 + 8 * c, o); }
    asm volatile("s_waitcnt lgkmcnt(0)" ::: "memory");
}
__device__ __forceinline__ void norm_phase(const CBuf& cb, const float* X, const float* g, const float* msc, const float* msh, bf16_t* U, int gw, int NGW, int lane) {
    for (int m0 = gw; m0 < MTOK; m0 += 4 * NGW) {
        f32x4 v[4][4];
#pragma unroll
        for (int r = 0; r < 4; ++r) { const f32x4* xr = (const f32x4*)(X + (size_t)(m0 + r * NGW) * DM) + lane;
#pragma unroll
            for (int j = 0; j < 4; ++j) v[r][j] = ld16bf(cb, xr + 64 * j); }
#pragma unroll
        for (int r = 0; r < 4; ++r) { const int m = m0 + r * NGW, b = m >> 11; float s = 0.f;
#pragma unroll
            for (int j = 0; j < 4; ++j) s += (v[r][j][0] * v[r][j][0] + v[r][j][1] * v[r][j][1]) + (v[r][j][2] * v[r][j][2] + v[r][j][3] * v[r][j][3]);
            const float rstd = rsqrtf(wave_sum(s) * (1.f / DM) + EPS);
#pragma unroll
            for (int j = 0; j < 4; ++j) { const int c = 4 * lane + 256 * j;
                const f32x4 gg = *(const f32x4*)(g + c), sc = *(const f32x4*)(msc + (size_t)b * MODW + c), sh = *(const f32x4*)(msh + (size_t)b * MODW + c);
                const f32x4 y = v[r][j] * rstd * gg * (sc + 1.0f) + sh; u32x2 w; w.x = cvt_pk_bf16(y[0], y[1]); w.y = cvt_pk_bf16(y[2], y[3]);
                st8(U + (size_t)m * DM + c, w); } }
    }
}


#define LDS_BARRIER() asm volatile("s_waitcnt lgkmcnt(0)\n\ts_barrier" ::: "memory")
constexpr int AT_BUF = 71680, AT_KS = 0, AT_VT = 36864, AT_FK = 70656, AT_VS = 528;
__device__ __forceinline__ void attn_unit(const CBuf& cb, LAS unsigned char* lds, int b, int h, int qb, bf16_t* QF, const bf16_t* KF, const bf16_t* VTF, const float* FC, const float* qg, const float* kg) {
    int tid = threadIdx.x; asm volatile("" : "+v"(tid));
    const int lane = tid & 63, w = __builtin_amdgcn_readfirstlane(tid >> 6), l31 = lane & 31, hh = lane >> 5;
    const int q0 = qb * 256, qrow = q0 + 32 * w + l31; const size_t grow = (size_t)b * SEQ + qrow;
    const float* FCs = FC + ((size_t)b * 16 + h) * SEQ;
    const int krow0 = tid >> 3, kch = tid & 7;
    const bf16_t* ksrc = KF + ((size_t)b * SEQ + krow0) * DM + h * 64 + 8 * kch;
    const bf16_t* vsrc = VTF + (size_t)(h * 64) * MTOK + (size_t)b * SEQ;
    f32x4 kg0 = *(const f32x4*)(kg + h * 64 + 8 * kch), kg1 = *(const f32x4*)(kg + h * 64 + 8 * kch + 4);
    u32x4 kraw[4], vraw[4]; float fraw = 0.f;
#define AT_LOAD(st_) do { const int kv0_ = 256 * (st_); \
        _Pragma("unroll") for (int i = 0; i < 4; ++i) { kraw[i] = ld16b(cb, ksrc + (size_t)(kv0_ + 64 * i) * DM); \
            const int idx = tid + 512 * i, d = idx >> 5, ch = idx & 31; vraw[i] = ld16b(cb, vsrc + (size_t)d * MTOK + kv0_ + 8 * ch); } \
        if (tid < 256) fraw = ld4c(FCs + kv0_ + tid); } while (0)
    AT_LOAD(qb);
    bf16x8 qfrag[4];
    {
        const bf16_t* qp = QF + grow * DM + h * 64 + 8 * hh; u32x4 raw[4]; float ss = 0.f;
#pragma unroll
        for (int ks = 0; ks < 4; ++ks) raw[ks] = ld16b(cb, qp + 16 * ks);
#pragma unroll
        for (int ks = 0; ks < 4; ++ks)
#pragma unroll
            for (int i = 0; i < 4; ++i) { const float lo = bflo(raw[ks][i]), hi = bfhi(raw[ks][i]); ss += lo * lo + hi * hi; }
        ss += __shfl_xor(ss, 32);
        const float rs = rsqrtf(ss * (1.f / 64.f) + EPS) * (0.125f * LOG2E);
#pragma unroll
        for (int ks = 0; ks < 4; ++ks) { const float* gp = qg + h * 64 + 16 * ks + 8 * hh; const f32x4 g0 = *(const f32x4*)gp, g1 = *(const f32x4*)(gp + 4);
            u32x4 pk;
            pk.x = cvt_pk_bf16(bflo(raw[ks][0]) * rs * g0[0], bfhi(raw[ks][0]) * rs * g0[1]); pk.y = cvt_pk_bf16(bflo(raw[ks][1]) * rs * g0[2], bfhi(raw[ks][1]) * rs * g0[3]);
            pk.z = cvt_pk_bf16(bflo(raw[ks][2]) * rs * g1[0], bfhi(raw[ks][2]) * rs * g1[1]); pk.w = cvt_pk_bf16(bflo(raw[ks][3]) * rs * g1[2], bfhi(raw[ks][3]) * rs * g1[3]);
            qfrag[ks] = __builtin_bit_cast(bf16x8, pk); }
    }
    const float Fq = ld4c(FCs + qrow);
    float m_run = 0.f, l_run = 0.f; bool first = true; f32x16 oT[2], cinit;
#pragma unroll
    for (int r = 0; r < 16; ++r) { oT[0][r] = 0.f; oT[1][r] = 0.f; cinit[r] = Fq; }
    for (int it = 0; it <= qb; ++it) {
        const int st = qb - it;
        LAS unsigned char* B = lds + (it & 1) * AT_BUF;
#pragma unroll
        for (int i = 0; i < 4; ++i) {
            float kv[8]; float ss = 0.f;
#pragma unroll
            for (int j = 0; j < 4; ++j) { kv[2 * j] = bflo(kraw[i][j]); kv[2 * j + 1] = bfhi(kraw[i][j]); ss += kv[2 * j] * kv[2 * j] + kv[2 * j + 1] * kv[2 * j + 1]; }
            ss += __shfl_xor(ss, 1); ss += __shfl_xor(ss, 2); ss += __shfl_xor(ss, 4);
            const float rs = rsqrtf(ss * (1.f / 64.f) + EPS);
#pragma unroll
            for (int j = 0; j < 4; ++j) { kv[j] *= rs * kg0[j]; kv[4 + j] *= rs * kg1[j]; }
            *(LAS u32x4*)(B + AT_KS + (krow0 + 64 * i) * 144 + kch * 16) = pack8(kv);
            const int idx = tid + 512 * i, d = idx >> 5, ch = idx & 31;
            *(LAS u32x4*)(B + AT_VT + d * AT_VS + ch * 16) = vraw[i];
        }
        if (tid < 256) *(LAS float*)(B + AT_FK + tid * 4) = fraw;
        LDS_BARRIER();
        if (st > 0) AT_LOAD(st - 1);
        for (int sub = 3; sub >= 0; --sub) {
            const int kt = 4 * st + sub;
            if (64 * kt > q0 + 32 * w + 31) continue;
            const LAS unsigned char* Bk = B + AT_KS + (64 * sub) * 144;
            const LAS unsigned char* Bv = B + AT_VT + (64 * sub) * 2;
            const LAS unsigned char* Bf = B + AT_FK + (64 * sub) * 4;
            bf16x8 kf[2][4]; f32x4 fkv[2][4];
#pragma unroll
            for (int kb = 0; kb < 2; ++kb)
#pragma unroll
                for (int ks = 0; ks < 4; ++ks) kf[kb][ks] = *(const LAS bf16x8*)(Bk + (32 * kb + l31) * 144 + ks * 32 + hh * 16);
            f32x16 sT[2];
#pragma unroll
            for (int kb = 0; kb < 2; ++kb) { f32x16 acc = mfma32(kf[kb][0], qfrag[0], cinit);
#pragma unroll
                for (int ks = 1; ks < 4; ++ks) acc = mfma32(kf[kb][ks], qfrag[ks], acc);
                sT[kb] = acc; }
#pragma unroll
            for (int kb = 0; kb < 2; ++kb)
#pragma unroll
                for (int g = 0; g < 4; ++g) fkv[kb][g] = *(const LAS f32x4*)(Bf + (32 * kb + 8 * g + 4 * hh) * 4);
            u32x2 vlo[2][2][2], vhi[2][2][2];
#pragma unroll
            for (int kb = 0; kb < 2; ++kb)
#pragma unroll
                for (int s = 0; s < 2; ++s)
#pragma unroll
                    for (int db = 0; db < 2; ++db) { const LAS unsigned char* vp = Bv + (32 * db + l31) * AT_VS + (32 * kb + 16 * s + 4 * hh) * 2;
                        vlo[kb][s][db] = *(const LAS u32x2*)vp; vhi[kb][s][db] = *(const LAS u32x2*)(vp + 16); }
#pragma unroll
            for (int kb = 0; kb < 2; ++kb)
#pragma unroll
                for (int g = 0; g < 4; ++g)
#pragma unroll
                    for (int i = 0; i < 4; ++i) sT[kb][4 * g + i] -= fkv[kb][g][i];
            if (64 * kt + 63 > q0 + 32 * w) {
#pragma unroll
                for (int kb = 0; kb < 2; ++kb)
#pragma unroll
                    for (int r = 0; r < 16; ++r) { const int kvi = 64 * kt + 32 * kb + (r & 3) + 8 * (r >> 2) + 4 * hh; if (kvi > qrow) sT[kb][r] = -INFINITY; }
            }
#define MX3(a_, b_, c_) __builtin_fmaxf(__builtin_fmaxf((a_), (b_)), (c_))
            float mxa = MX3(sT[0][0], sT[0][1], sT[0][2]), mxb = MX3(sT[1][0], sT[1][1], sT[1][2]);
#pragma unroll
            for (int r = 3; r < 15; r += 2) { mxa = MX3(mxa, sT[0][r], sT[0][r + 1]); mxb = MX3(mxb, sT[1][r], sT[1][r + 1]); }
            float mx = MX3(mxa, mxb, __builtin_fmaxf(sT[0][15], sT[1][15]));
#undef MX3
            { const auto rr = __builtin_amdgcn_permlane32_swap(__float_as_uint(mx), __float_as_uint(mx), false, false); mx = fmaxf(__uint_as_float(rr[0]), __uint_as_float(rr[1])); }
            if (first || __builtin_amdgcn_ballot_w64(mx > 0.f) != 0ull) {
                const float dl = first ? mx : fmaxf(mx, 0.f), alpha = first ? 1.f : __builtin_amdgcn_exp2f(-dl);
                m_run += dl; l_run *= alpha; first = false;
#pragma unroll
                for (int r = 0; r < 16; ++r) { oT[0][r] *= alpha; oT[1][r] *= alpha; sT[0][r] -= dl; sT[1][r] -= dl; cinit[r] = Fq - m_run; }
            }
            float ps = 0.f;
#pragma unroll
            for (int kb = 0; kb < 2; ++kb)
#pragma unroll
                for (int r = 0; r < 16; ++r) { const float p = __builtin_amdgcn_exp2f(sT[kb][r]); sT[kb][r] = p; ps += p; }
            { const auto rr = __builtin_amdgcn_permlane32_swap(__float_as_uint(ps), __float_as_uint(ps), false, false); ps = __uint_as_float(rr[0]) + __uint_as_float(rr[1]); }
            l_run += ps;
#pragma unroll
            for (int kb = 0; kb < 2; ++kb)
#pragma unroll
                for (int s = 0; s < 2; ++s) { u32x4 pk; pk.x = cvt_pk_bf16(sT[kb][8 * s + 0], sT[kb][8 * s + 1]); pk.y = cvt_pk_bf16(sT[kb][8 * s + 2], sT[kb][8 * s + 3]);
                    pk.z = cvt_pk_bf16(sT[kb][8 * s + 4], sT[kb][8 * s + 5]); pk.w = cvt_pk_bf16(sT[kb][8 * s + 6], sT[kb][8 * s + 7]);
                    const bf16x8 pf = __builtin_bit_cast(bf16x8, pk);
#pragma unroll
                    for (int db = 0; db < 2; ++db) { u32x4 av; av.x = vlo[kb][s][db].x; av.y = vlo[kb][s][db].y; av.z = vhi[kb][s][db].x; av.w = vhi[kb][s][db].y;
                        oT[db] = mfma32(__builtin_bit_cast(bf16x8, av), pf, oT[db]); } }
        }
    }
#undef AT_LOAD
    {
        const float inv = 1.0f / l_run; bf16_t* op = QF + grow * DM + h * 64;
#pragma unroll
        for (int db = 0; db < 2; ++db)
#pragma unroll
            for (int g = 0; g < 4; ++g) { u32x2 o; o.x = cvt_pk_bf16(oT[db][4 * g] * inv, oT[db][4 * g + 1] * inv); o.y = cvt_pk_bf16(oT[db][4 * g + 2] * inv, oT[db][4 * g + 3] * inv);
                st8(op + 32 * db + 8 * g + 4 * hh, o); }
    }
    LDS_BARRIER();
}

constexpr int ML_QS = 0, ML_KS = 17408, ML_KWT = 34816, ML_VT = 53248, ML_SP = 90112, ML_HST = 99328, ML_FV = 133120;
__device__ __forceinline__ void mlstm_item(const CBuf& cb, LAS unsigned char* lds, int item, unsigned char* wsb, const bf16_t* QKM, const bf16_t* VTM, bf16_t* OM, const float* GATES, const float* convw, const float* convb, const float* normg) {
    const int b = item >> 2, h = item & 3;
    const int tid0 = threadIdx.x, w = __builtin_amdgcn_readfirstlane(tid0 >> 6);
    LAS float* fv = (LAS float*)(lds + ML_FV);
    LAS float* bvec = fv, *avec = fv + 64, *mtv = fv + 128, *winter = fv + 192, *qn = fv + 320, *rowsum = fv + 384, *emt = fv + 448, *nvec = fv + 512, *scal = fv + 640;
    LAS float* mprev = (LAS float*)(lds + ML_FV + 4096), *mnew = mprev + 32, *blastv = mprev + 64, *mxwv = mprev + 96;
    float* GV = (float*)(wsb + WS_GV) + (size_t)item * (32 * 256);
    f32x16 Cacc[4];
#pragma unroll
    for (int d = 0; d < 4; ++d)
#pragma unroll
        for (int r = 0; r < 16; ++r) Cacc[d][r] = 0.f;
    if (tid0 < 128) nvec[tid0] = 0.f;
    {
        int tid = tid0; asm volatile("" : "+v"(tid)); const int lane = tid & 63;
#pragma unroll
        for (int ci = 0; ci < 4; ++ci) { const int c = w + 8 * ci; const size_t tn = (size_t)b * SEQ + 64 * c;
            const float ig = ld4c(GATES + (tn + lane) * 32 + h), fg = ld4c(GATES + (tn + lane) * 32 + 4 + h);
            float bs = logsig_f(fg);
#pragma unroll
            for (int o = 1; o < 64; o <<= 1) { const float t = __shfl_up(bs, o); if (lane >= o) bs += t; }
            const float a = ig - bs; float cm = a;
#pragma unroll
            for (int o = 1; o < 64; o <<= 1) { const float t = __shfl_up(cm, o); if (lane >= o) cm = fmaxf(cm, t); }
            const float blast = __shfl(bs, 63);
            float mxw = blast - bs + ig;
#pragma unroll
            for (int o = 1; o < 64; o <<= 1) mxw = fmaxf(mxw, __shfl_xor(mxw, o));
            float* g = GV + c * 256 + lane;
            __hip_atomic_store((unsigned*)(g), __float_as_uint(bs), __ATOMIC_RELAXED, __HIP_MEMORY_SCOPE_AGENT);
            __hip_atomic_store((unsigned*)(g + 64), __float_as_uint(a), __ATOMIC_RELAXED, __HIP_MEMORY_SCOPE_AGENT);
            __hip_atomic_store((unsigned*)(g + 128), __float_as_uint(cm), __ATOMIC_RELAXED, __HIP_MEMORY_SCOPE_AGENT);
            __hip_atomic_store((unsigned*)(g + 192), __float_as_uint(ig), __ATOMIC_RELAXED, __HIP_MEMORY_SCOPE_AGENT);
            if (lane == 0) { blastv[c] = blast; mxwv[c] = mxw; } }
        asm volatile("s_waitcnt vmcnt(0)" ::: "memory");
        __syncthreads();
        if (tid < 64) { float m = 0.f;
            float mp_keep = 0.f, mn_keep = 0.f;
#pragma unroll 1
            for (int c = 0; c < 32; ++c) { const float mn = fmaxf(blastv[c] + m, mxwv[c]); if (lane == c) { mp_keep = m; mn_keep = mn; } m = mn; }
            if (lane < 32) { mprev[lane] = mp_keep; mnew[lane] = mn_keep; } }
        __syncthreads();
    }
    u32x4 raw[7], vt[4]; f32x4 bs4 = (f32x4){0.f, 0.f, 0.f, 0.f}, ig4 = bs4; float gbs = 0.f, ga = 0.f, gcm = 0.f;
#define ML_IDX const int lane = tid & 63, l31 = lane & 31, hh = lane >> 5, fr = lane & 15, fq = lane >> 4; \
        const int cc = tid & 31, rg = tid >> 5; const bool isk = cc >= 16; const int chl = isk ? 512 + h * 128 + 8 * (cc - 16) : h * 128 + 8 * cc; \
        (void)l31; (void)hh; (void)fr; (void)fq;
#define ML_LOAD(cn) do { const size_t tn = (size_t)b * SEQ + 64 * (cn); \
        _Pragma("unroll") for (int jr = 0; jr < 7; ++jr) { const int tl = 4 * rg - 3 + jr; if ((cn) > 0 || tl >= 0) raw[jr] = ld16b(cb, QKM + (size_t)((long)tn + tl) * DM + chl); else raw[jr] = (u32x4){0u, 0u, 0u, 0u}; } \
        _Pragma("unroll") for (int i = 0; i < 4; ++i) { const int idx = tid + 512 * i, e = idx >> 3, ch = idx & 7; vt[i] = ld16b(cb, VTM + (size_t)(h * 256 + e) * MTOK + tn + 8 * ch); } \
        if (isk) { bs4 = ld16bf(cb, GV + (cn) * 256 + 4 * rg); ig4 = ld16bf(cb, GV + (cn) * 256 + 192 + 4 * rg); } \
        if (w == 0) { gbs = ld4c(GV + (cn) * 256 + lane); ga = ld4c(GV + (cn) * 256 + 64 + lane); gcm = ld4c(GV + (cn) * 256 + 128 + lane); } } while (0)
#define ML_OMLOAD(cprev) do { const size_t tp = (size_t)b * SEQ + 64 * (cprev); \
        _Pragma("unroll") for (int rr = 0; rr < 8; ++rr) om[rr] = ld8c(OM + (tp + 8 * w + rr) * DM + h * 256 + 4 * lane); \
        gnorm = *(const f32x4*)(normg + h * 256 + 4 * lane); } while (0)
#define ML_STEP5(cprev) do { const size_t tp = (size_t)b * SEQ + 64 * (cprev); \
        _Pragma("unroll") for (int rr = 0; rr < 8; ++rr) { const int t = 8 * w + rr; const u32x2 hv = *(const LAS u32x2*)(lds + ML_HST + t * 528 + lane * 8); \
            const float h0 = bflo(hv.x), h1 = bfhi(hv.x), h2 = bflo(hv.y), h3 = bfhi(hv.y); \
            const float rstd = rsqrtf(wave_sum((h0 * h0 + h1 * h1) + (h2 * h2 + h3 * h3)) * (1.f / 256.f) + EPS); \
            bf16_t* op = OM + (tp + t) * DM + h * 256 + 4 * lane; const u32x2 ov = om[rr]; const f32x4 g = gnorm; \
            u32x2 o; o.x = cvt_pk_bf16(sigmoid_f(bflo(ov.x)) * h0 * rstd * g[0], sigmoid_f(bfhi(ov.x)) * h1 * rstd * g[1]); \
            o.y = cvt_pk_bf16(sigmoid_f(bflo(ov.y)) * h2 * rstd * g[2], sigmoid_f(bfhi(ov.y)) * h3 * rstd * g[3]); \
            st8(op, o); } } while (0)
    u32x2 om[8]; f32x4 gnorm;
    { int tid = tid0; asm volatile("" : "+v"(tid)); ML_IDX; ML_LOAD(0); }
    for (int c = 0; c < 32; ++c) {
        int tid = tid0; asm volatile("" : "+v"(tid));
        ML_IDX;
        const float mp = mprev[c], mn = mnew[c], bl = blastv[c];
        if (w == 0) {
            const float mt_ = fmaxf(gbs + mp, gbs + gcm);
            bvec[lane] = gbs; avec[lane] = ga; mtv[lane] = mt_; winter[lane] = expf(gbs + mp - mt_); emt[lane] = expf(-mt_);
            if (lane == 0) scal[0] = expf(bl + mp - mn);
        }
        {
            const float* cwp = convw; const float* cbp = convb;
            f32x4 cw[4][2], cbv[2];
#pragma unroll
            for (int j = 0; j < 4; ++j) { cw[j][0] = *(const f32x4*)(cwp + j * 1024 + chl); cw[j][1] = *(const f32x4*)(cwp + j * 1024 + chl + 4); }
            cbv[0] = *(const f32x4*)(cbp + chl); cbv[1] = *(const f32x4*)(cbp + chl + 4);
            float outv[4][8];
#pragma unroll
            for (int i = 0; i < 8; ++i) {
                float x[7];
#pragma unroll
                for (int jr = 0; jr < 7; ++jr) x[jr] = (i & 1) ? bfhi(raw[jr][i >> 1]) : bflo(raw[jr][i >> 1]);
#pragma unroll
                for (int o = 0; o < 4; ++o) { float v = cbv[i >> 2][i & 3];
#pragma unroll
                    for (int j = 0; j < 4; ++j) v += cw[j][i >> 2][i & 3] * x[o + j];
                    v = v * __builtin_amdgcn_rcpf(1.f + __expf(-v)); outv[o][i] = isk ? v * 0.08838834764831845f : v; }
            }
            if (!isk) {
#pragma unroll
                for (int o = 0; o < 4; ++o) *(LAS u32x4*)(lds + ML_QS + (4 * rg + o) * 272 + cc * 16) = pack8(outv[o]);
            } else {
#pragma unroll
                for (int o = 0; o < 4; ++o) *(LAS u32x4*)(lds + ML_KS + (4 * rg + o) * 272 + (cc - 16) * 16) = pack8(outv[o]);
                f32x4 wk4;
#pragma unroll
                for (int j = 0; j < 4; ++j) wk4[j] = expf(bl - bs4[j] + ig4[j] - mn);
#pragma unroll
                for (int i = 0; i < 8; ++i) { u32x2 p; p.x = cvt_pk_bf16(outv[0][i] * wk4[0], outv[1][i] * wk4[1]); p.y = cvt_pk_bf16(outv[2][i] * wk4[2], outv[3][i] * wk4[3]);
                    *(LAS u32x2*)(lds + ML_KWT + (8 * (cc - 16) + i) * 144 + rg * 8) = p; }
            }
#pragma unroll
            for (int i = 0; i < 4; ++i) { const int idx = tid + 512 * i, e = idx >> 3, ch = idx & 7; *(LAS u32x4*)(lds + ML_VT + e * 144 + ch * 16) = vt[i]; }
            if (tid < 64) rowsum[tid] = 0.f;
        }
        if (c + 1 < 32) ML_LOAD(c + 1);
        if (c > 0) ML_STEP5(c - 1);
        LDS_BARRIER();
        {
            const int rb = w >> 1;
#pragma unroll
            for (int ci = 0; ci < 2; ++ci) { const int cb = 2 * (w & 1) + ci;
                if (cb <= rb) {
                    f32x4 acc = (f32x4){0.f, 0.f, 0.f, 0.f};
#pragma unroll
                    for (int ks = 0; ks < 4; ++ks) { const bf16x8 a = *(const LAS bf16x8*)(lds + ML_QS + (16 * rb + fr) * 272 + (32 * ks + 8 * fq) * 2);
                        const bf16x8 bb = *(const LAS bf16x8*)(lds + ML_KS + (16 * cb + fr) * 272 + (32 * ks + 8 * fq) * 2); acc = mfma16(a, bb, acc); }
                    const int s = 16 * cb + fr; const float as = avec[s];
#pragma unroll
                    for (int j = 0; j < 4; ++j) { const int t = 16 * rb + 4 * fq + j; float v = (s <= t) ? acc[j] * __expf(bvec[t] + as - mtv[t]) : 0.f;
                        *(LAS bf16_t*)(lds + ML_SP + t * 144 + s * 2) = (bf16_t)(cvt_pk_bf16(v, 0.f) & 0xffffu);
                        v += __shfl_xor(v, 1); v += __shfl_xor(v, 2); v += __shfl_xor(v, 4); v += __shfl_xor(v, 8);
                        if (fr == 0) __hip_atomic_fetch_add(rowsum + t, v, __ATOMIC_RELAXED, __HIP_MEMORY_SCOPE_WORKGROUP); }
                } else {
#pragma unroll
                    for (int j = 0; j < 4; ++j) *(LAS bf16_t*)(lds + ML_SP + (16 * rb + 4 * fq + j) * 144 + (16 * cb + fr) * 2) = (bf16_t)0;
                }
            }
            const int t = tid >> 3, part = tid & 7;
            const u32x4 qa = *(const LAS u32x4*)(lds + ML_QS + t * 272 + part * 32), qb2 = *(const LAS u32x4*)(lds + ML_QS + t * 272 + part * 32 + 16);
            float s = 0.f;
#pragma unroll
            for (int i = 0; i < 4; ++i) { s += bflo(qa[i]) * nvec[16 * part + 2 * i] + bfhi(qa[i]) * nvec[16 * part + 2 * i + 1]; s += bflo(qb2[i]) * nvec[16 * part + 8 + 2 * i] + bfhi(qb2[i]) * nvec[16 * part + 8 + 2 * i + 1]; }
            s += __shfl_xor(s, 1); s += __shfl_xor(s, 2); s += __shfl_xor(s, 4);
            if (part == 0) qn[t] = s;
        }
        LDS_BARRIER();
        ML_OMLOAD(c);
        {
            const float decay = scal[0];
            bf16x8 bv[4];
#pragma unroll
            for (int ks = 0; ks < 4; ++ks) bv[ks] = *(const LAS bf16x8*)(lds + ML_VT + (32 * w + l31) * 144 + (16 * ks + 8 * hh) * 2);
            f32x16 num[2];
#pragma unroll
            for (int r = 0; r < 16; ++r) { num[0][r] = 0.f; num[1][r] = 0.f; }
#pragma unroll
            for (int db = 0; db < 4; ++db)
#pragma unroll
                for (int s = 0; s < 2; ++s) { u32x4 pk; pk.x = cvt_pk_bf16(Cacc[db][8 * s + 0], Cacc[db][8 * s + 1]); pk.y = cvt_pk_bf16(Cacc[db][8 * s + 2], Cacc[db][8 * s + 3]);
                    pk.z = cvt_pk_bf16(Cacc[db][8 * s + 4], Cacc[db][8 * s + 5]); pk.w = cvt_pk_bf16(Cacc[db][8 * s + 6], Cacc[db][8 * s + 7]); const bf16x8 cf = __builtin_bit_cast(bf16x8, pk);
#pragma unroll
                    for (int tb = 0; tb < 2; ++tb) { const LAS unsigned char* qp = lds + ML_QS + (32 * tb + l31) * 272 + (32 * db + 16 * s + 4 * hh) * 2;
                        const u32x2 lo = *(const LAS u32x2*)qp, hi = *(const LAS u32x2*)(qp + 16); u32x4 av; av.x = lo.x; av.y = lo.y; av.z = hi.x; av.w = hi.y;
                        num[tb] = mfma32(__builtin_bit_cast(bf16x8, av), cf, num[tb]); } }
#pragma unroll
            for (int tb = 0; tb < 2; ++tb) {
                f32x16 acc = num[tb];
#pragma unroll
                for (int g = 0; g < 4; ++g) { const f32x4 wi = *(const LAS f32x4*)(winter + 32 * tb + 8 * g + 4 * hh);
#pragma unroll
                    for (int i = 0; i < 4; ++i) acc[4 * g + i] *= wi[i]; }
#pragma unroll
                for (int ks = 0; ks < 4; ++ks) { const bf16x8 a = *(const LAS bf16x8*)(lds + ML_SP + (32 * tb + l31) * 144 + (16 * ks + 8 * hh) * 2); acc = mfma32(a, bv[ks], acc); }
#pragma unroll
                for (int g = 0; g < 4; ++g) { const int r0 = 32 * tb + 8 * g + 4 * hh;
                    const f32x4 wi = *(const LAS f32x4*)(winter + r0), q4 = *(const LAS f32x4*)(qn + r0), rs4 = *(const LAS f32x4*)(rowsum + r0), em4 = *(const LAS f32x4*)(emt + r0);
#pragma unroll
                    for (int i = 0; i < 4; ++i) { const float den = wi[i] * q4[i] + rs4[i]; const float dn = fmaxf(fabsf(den), em4[i]); const float hv = acc[4 * g + i] * __builtin_amdgcn_rcpf(dn);
                        *(LAS bf16_t*)(lds + ML_HST + (r0 + i) * 528 + (32 * w + l31) * 2) = (bf16_t)(cvt_pk_bf16(hv, 0.f) & 0xffffu); } }
            }
#pragma unroll
            for (int db = 0; db < 4; ++db) {
#pragma unroll
                for (int r = 0; r < 16; ++r) Cacc[db][r] *= decay;
#pragma unroll
                for (int ks = 0; ks < 4; ++ks) { const bf16x8 a = *(const LAS bf16x8*)(lds + ML_KWT + (32 * db + l31) * 144 + (16 * ks + 8 * hh) * 2); Cacc[db] = mfma32(a, bv[ks], Cacc[db]); }
            }
            const int d = tid >> 2, part = tid & 3;
            const u32x4 ka = *(const LAS u32x4*)(lds + ML_KWT + d * 144 + part * 32), kb2 = *(const LAS u32x4*)(lds + ML_KWT + d * 144 + part * 32 + 16);
            float s = 0.f;
#pragma unroll
            for (int i = 0; i < 4; ++i) s += (bflo(ka[i]) + bfhi(ka[i])) + (bflo(kb2[i]) + bfhi(kb2[i]));
            s += __shfl_xor(s, 1); s += __shfl_xor(s, 2);
            if (part == 0) nvec[d] = decay * nvec[d] + s;
        }
        LDS_BARRIER();
    }
    { int tid = tid0; asm volatile("" : "+v"(tid)); const int lane = tid & 63; ML_STEP5(31); }
    __syncthreads();
#undef ML_IDX
#undef ML_LOAD
#undef ML_STEP5
#undef ML_OMLOAD
}


#define XB_TMO      128
#define XB_XCNT(j)  (256  + 64 * (j))
#define XB_XSUB(j)  (1280 + 64 * (j))
#define XB_XGEN(j)  (2304 + 64 * (j))
#define XB_TOP      3328
#define XB_TOPGEN   3392
#define XCD_BAR_WORDS 3456
#define XB_SPIN_CAP (1u << 18)

__device__ __forceinline__ unsigned xb_ld(unsigned* p)              { return __hip_atomic_load(p, __ATOMIC_RELAXED, __HIP_MEMORY_SCOPE_AGENT); }
__device__ __forceinline__ unsigned xb_add(unsigned* p, unsigned v) { return __hip_atomic_fetch_add(p, v, __ATOMIC_RELAXED, __HIP_MEMORY_SCOPE_AGENT); }
__device__ __forceinline__ unsigned xb_xcc_id() { return (unsigned)__builtin_amdgcn_s_getreg((3 << 11) | 20) & 0xFu; }
#define XB_SPIN(cond, bar) do { unsigned _sp = 0; while (cond) { __builtin_amdgcn_s_sleep(1); \
    if ((++_sp & 255u) == 0u) { if (xb_ld(&(bar)[XB_TMO])) break; if (_sp > XB_SPIN_CAP) { atomicAdd(&(bar)[XB_TMO], 1u); break; } } } } while (0)

struct XcdBarrier {
    unsigned* bar; unsigned x;
    volatile LAS unsigned* st;
};

__device__ __forceinline__ XcdBarrier xcd_barrier_post(unsigned* bar, volatile LAS unsigned* st) {
    XcdBarrier b; b.bar = bar; b.x = xb_xcc_id(); b.st = st;
    if (threadIdx.x == 0) (void)xb_add(&bar[XB_XCNT(b.x)], 1u);
    return b;
}
__device__ __forceinline__ void xcd_barrier_complete(unsigned* bar, unsigned x, unsigned& nloc, unsigned& nx) {
    const unsigned G = gridDim.x * gridDim.y * gridDim.z;
    unsigned sum, cnt, mine, sp = 0u;
    for (;;) {
        sum = 0u; cnt = 0u; mine = 0u;
#pragma unroll
        for (unsigned j = 0; j < 16; ++j) { const unsigned c = xb_ld(&bar[XB_XCNT(j)]); sum += c; cnt += (c > 0u) ? 1u : 0u; mine = (j == x) ? c : mine; }
        if (sum == G) break;
        __builtin_amdgcn_s_sleep(1);
        if ((++sp & 255u) == 0u) { if (xb_ld(&bar[XB_TMO])) break; if (sp > XB_SPIN_CAP) { atomicAdd(&bar[XB_TMO], 1u); break; } }
    }
    nloc = mine > 0u ? mine : 1u; nx = cnt > 0u ? cnt : 1u;
}

__device__ __forceinline__ void xcd_barrier(const XcdBarrier& b) {
    asm volatile("s_waitcnt vmcnt(0)" ::: "memory");
    __syncthreads();
    if (threadIdx.x == 0) {
        unsigned* bar = b.bar;
        __builtin_amdgcn_s_waitcnt(0);
        unsigned nloc = b.st[0], nx = b.st[1];
        if (nloc == 0u) { xcd_barrier_complete(bar, b.x, nloc, nx); b.st[0] = nloc; b.st[1] = nx; }
        const unsigned old = xb_add(&bar[XB_XSUB(b.x)], 1u);
        const unsigned gen = old / nloc;
        if (old + 1u == (gen + 1u) * nloc) {
            __builtin_amdgcn_fence(__ATOMIC_RELEASE, "agent");
            asm volatile("s_waitcnt vmcnt(0)" ::: "memory");
            const unsigned og = xb_add(&bar[XB_TOP], 1u);
            const unsigned tg = og / nx;
            if (og + 1u == (tg + 1u) * nx) xb_add(&bar[XB_TOPGEN], 1u);
            else XB_SPIN(xb_ld(&bar[XB_TOPGEN]) == tg, bar);
            __builtin_amdgcn_fence(__ATOMIC_ACQUIRE, "agent");
            xb_add(&bar[XB_XGEN(b.x)], 1u);
            asm volatile("s_waitcnt vmcnt(0)" ::: "memory");
        } else {
            XB_SPIN(xb_ld(&bar[XB_XGEN(b.x)]) == gen, bar);
            __builtin_amdgcn_fence(__ATOMIC_ACQUIRE, "agent");
            asm volatile("s_waitcnt vmcnt(0)" ::: "memory");
        }
    }
    __syncthreads();
}

struct Args { const float* in[21]; float* out; unsigned char* ws; int nsteps, pad0; unsigned char sched[48]; };
constexpr int N_PHASES = 15;
__global__ void __launch_bounds__(512) fwd(Args a) {
    extern __shared__ __attribute__((aligned(16))) unsigned char lds_[];
    LAS unsigned char* lds = (LAS unsigned char*)lds_;
    cg::grid_group grid = cg::this_grid();
    const int G = gridDim.x, NGW = G * 8;
    unsigned char* ws = a.ws;
    const float* x = a.in[0]; float* out = a.out;
    float* mod = (float*)(ws + WS_MOD);
    bf16_t* U = (bf16_t*)(ws + WS_U); bf16_t* HID = (bf16_t*)(ws + WS_HID);
    const float* bmix = a.in[9];
    volatile LAS unsigned* MISC = (volatile LAS unsigned*)(lds + LDS_ITEM + 64);
    if (threadIdx.x < 16) MISC[threadIdx.x] = 0u;
    __syncthreads();
    XcdBarrier bar = xcd_barrier_post((unsigned*)(ws + WS_CNT) + 4096, MISC);
    if (a.nsteps > 1) grid.sync();
#define IN(k) (ph == (k))
#define SEAM(k) do { } while (0)
#ifndef MK_SC1A
#define MK_SC1A false
#endif
#define RUN_GEMM(EPI, E, Aop, Bop, Mr, Nr, Kr) RUN_GEMM_X(EPI, E, Aop, Bop, Mr, Nr, Kr, MK_SC1A, false)
#define RUN_GEMM_X(EPI, E, Aop, Bop, Mr, Nr, Kr, CA, CB) do { pg8::Gemm g_{(const bf16_t*)(Aop), (const bf16_t*)(Bop), (Mr), (Nr), (Kr)}; pg8::StaticOrder S_; S_.init((Mr), (Nr), G, (int)blockIdx.x); \
        pg8::gemm_phase<EPI, pg8::StaticOrder, true, true, CA, CB>(lds, g_, S_, E); } while (0)
#define RUN_GEMM_L(EPI, E, Aop, Bop, Mr, Nr, Kr, CA, CB) do { pg8::Gemm g_{(const bf16_t*)(Aop), (const bf16_t*)(Bop), (Mr), (Nr), (Kr)}; pg8::StaticOrder S_; S_.init((Mr), (Nr), G, (int)blockIdx.x); \
        pg8::gemm_phase<EPI, pg8::StaticOrder, false, true, CA, CB>(lds, g_, S_, E); } while (0)

    int n7 = 0;
    const CBuf cbw = make_cbuf(ws, (unsigned)WS_NEED), cbo = make_cbuf(out, (unsigned)((size_t)MTOK * DM * 4)), cbx = make_cbuf(x, (unsigned)((size_t)MTOK * DM * 4));
    for (int step = 0; step < a.nsteps; ++step) {
    const int ph = a.sched[step];
    int tid = threadIdx.x; asm volatile("" : "+v"(tid));
    const int lane = tid & 63, w = __builtin_amdgcn_readfirstlane(tid >> 6), gw = blockIdx.x * 8 + w;
    if (IN(0)) {
        if (blockIdx.x < 144) {
            LAS float* sc = (LAS float*)lds; const float* cin = a.in[1];
            for (int i = tid; i < 16384; i += 512) { const float v = cin[i]; sc[i] = v / (1.f + expf(-v)); }
            __syncthreads();
            const int n = blockIdx.x * 64 + lane, k0 = w * 128; const float* wada = a.in[2];
            float acc[16];
#pragma unroll
            for (int bb = 0; bb < 16; ++bb) acc[bb] = 0.f;
#pragma unroll 16
            for (int k = 0; k < 128; ++k) { const float wv = wada[(size_t)(k0 + k) * MODW + n];
#pragma unroll
                for (int bb = 0; bb < 16; ++bb) acc[bb] += sc[bb * 1024 + k0 + k] * wv; }
            LAS float* red = (LAS float*)(lds + 65536);
#pragma unroll
            for (int bb = 0; bb < 16; ++bb) red[(w * 16 + bb) * 64 + lane] = acc[bb];
            __syncthreads();
            for (int i = tid; i < 1024; i += 512) { const int bb = i >> 6, l = i & 63; float s = a.in[3][blockIdx.x * 64 + l];
#pragma unroll
                for (int ww = 0; ww < 8; ++ww) s += red[(ww * 16 + bb) * 64 + l];
                __hip_atomic_store((unsigned*)(mod + (size_t)bb * MODW + blockIdx.x * 64 + l), __float_as_uint(s), __ATOMIC_RELAXED, __HIP_MEMORY_SCOPE_AGENT); }
            __syncthreads();
        }
        {
            LAS float* scr = (LAS float*)(lds + w * 16640);
            constexpr int I_FI = 16 * 88, I_FO = 44 * 16, I_Z = 16 * 64, I_V = 16 * 32, I_G = 16 * 32, I_S = 16 * 16;
            constexpr int NITEMS = 2 * (I_FI + I_FO) + I_Z + I_V + I_G + 3 * I_S;
            for (int it = gw; it < NITEMS; it += NGW) {
                int r = it;
                if (r < 2 * (I_FI + I_FO)) {
                    const int which = r >= (I_FI + I_FO); if (which) r -= (I_FI + I_FO);
                    if (r < I_FI) { const int kb = r / 88, g = r % 88, p = g >> 2, half = (g >> 1) & 1, jj = g & 1;
                        tr_item(a.in[which ? 19 : 5], 1024, 5632, half * 2816 + 128 * p + 64 * jj, 64 * kb, (bf16_t*)(ws + (which ? WS_BT2I : WS_BT1I)), 64 * g, scr, lane); }
                    else { r -= I_FI; const int kb = r / 16, g = r % 16; tr_item(a.in[which ? 20 : 6], 2816, 1024, 64 * g, 64 * kb, (bf16_t*)(ws + (which ? WS_BT2O : WS_BT1O)), 64 * g, scr, lane); }
                    continue;
                }
                r -= 2 * (I_FI + I_FO);
                if (r < I_Z) { const int kb = r / 64, g = r % 64, dr0 = 64 * g; const int sc0 = dr0 < 1024 ? dr0 : dr0 < 2048 ? 2048 + (dr0 - 1024) : dr0 < 3072 ? 3080 + (dr0 - 2048) : 4104 + (dr0 - 3072);
                    tr_item(a.in[8], 1024, MIXW, sc0, 64 * kb, (bf16_t*)(ws + WS_BTZ), dr0, scr, lane); continue; }
                r -= I_Z;
                if (r < I_V) { const int kb = r / 32, g = r % 32, dr0 = 64 * g; const int sc0 = dr0 < 1024 ? 1024 + dr0 : 5128 + (dr0 - 1024);
                    tr_item(a.in[8], 1024, MIXW, sc0, 64 * kb, (bf16_t*)(ws + WS_WVT), dr0, scr, lane); continue; }
                r -= I_V;
                if (r < I_G) { const int kb = r / 32, g = r % 32, dr0 = 64 * g; tr_item(a.in[8], 1024, MIXW, 6168 + dr0, 64 * kb, (bf16_t*)(ws + WS_BTG), dr0, scr, lane); continue; }
                r -= I_G;
                { const int which = r / I_S; r %= I_S; const int kb = r / 16, g = r % 16;
                  tr_item(a.in[15 + which], 1024, 1024, 64 * g, 64 * kb, (bf16_t*)(ws + (which == 0 ? WS_BTA : which == 1 ? WS_BTB : WS_BTO)), 64 * g, scr, lane); }
            }
            bf16_t* BTZ = (bf16_t*)(ws + WS_BTZ); const float* wmix = a.in[8];
            for (int i = blockIdx.x * 512 + tid; i < 256 * 128; i += G * 512) { const int rr = i >> 7, k0 = (i & 127) * 8; const int col = rr < 8 ? 3072 + rr : rr < 24 ? 6152 + (rr - 8) : -1;
                float v[8];
#pragma unroll
                for (int j = 0; j < 8; ++j) v[j] = col >= 0 ? wmix[(size_t)(k0 + j) * MIXW + col] : 0.f;
                st16(BTZ + (size_t)(4096 + rr) * 1024 + k0, pack8(v)); }
        }
    }
    SEAM(0);
    if (IN(1)) norm_phase(cbx, x, a.in[4], mod + 1 * 1024, mod + 0 * 1024, U, gw, NGW, lane);
    SEAM(1);
    if (IN(2)) { EpiSwiglu E{HID}; RUN_GEMM(EpiSwiglu, E, U, ws + WS_BT1I, MTOK, 5632, 1024); }
    SEAM(2);
    if (IN(3)) { EpiRes E{x, out, mod + 2 * 1024, 0.5f, cbo, false}; RUN_GEMM_L(EpiRes, E, HID, ws + WS_BT1O, MTOK, 1024, 2816, MK_SC1A, false); }
    SEAM(3);
    if (IN(4)) norm_phase(cbo, out, a.in[7], mod + 4 * 1024, mod + 3 * 1024, U, gw, NGW, lane);
    SEAM(4);
    if (IN(5)) {
        { EpiZ E{ws, bmix}; RUN_GEMM(EpiZ, E, U, ws + WS_BTZ, MTOK, 4352, 1024); }
        { EpiVT E{ws, bmix}; RUN_GEMM_X(EpiVT, E, ws + WS_WVT, U, 2048, MTOK, 1024, false, MK_SC1A); }
    }
    SEAM(5);
    if (IN(6)) {
        const float* GT = (const float*)(ws + WS_GATES); float* FC = (float*)(ws + WS_FC);
        for (int seq = gw; seq < 256; seq += NGW) { const int bb = seq >> 4, h_ = seq & 15; float v[32]; float s = 0.f;
#pragma unroll
            for (int i = 0; i < 32; ++i) { const float f = ld4c(GT + ((size_t)bb * SEQ + 32 * lane + i) * 32 + 8 + h_); s += logsig_f(f); v[i] = s; }
            float inc = s;
#pragma unroll
            for (int o = 1; o < 64; o <<= 1) { const float t = __shfl_up(inc, o); if (lane >= o) inc += t; }
            const float exc = inc - s;
#pragma unroll
            for (int i = 0; i < 32; i += 4) st16f(FC + (size_t)seq * SEQ + 32 * lane + i, (f32x4){(v[i] + exc) * LOG2E, (v[i + 1] + exc) * LOG2E, (v[i + 2] + exc) * LOG2E, (v[i + 3] + exc) * LOG2E});
        }
    }
    SEAM(6);
    if (IN(7) || IN(15) || IN(16)) {
        unsigned* cnt = (unsigned*)(ws + WS_CNT) + 64 * n7; ++n7; LAS int* s_item = (LAS int*)(lds + LDS_ITEM);
        const int item_lo = IN(15) ? 64 : 0, item_hi = IN(16) ? 64 : 64 + 2048;
        for (;;) {
            if (tid == 0) *s_item = item_lo + (int)atomicAdd(cnt, 1u);
            __syncthreads();
            const int item = *s_item;
            __syncthreads();
            if (item >= item_hi) break;
            if (item < 64) mlstm_item(cbw, lds, item, ws, (const bf16_t*)(ws + WS_QKM), (const bf16_t*)(ws + WS_VTM), (bf16_t*)(ws + WS_OM), (const float*)(ws + WS_GATES), a.in[10], a.in[11], a.in[12]);
            else { const int idx = item - 64, bh = idx & 255, qb = 7 - (idx >> 8);
                attn_unit(cbw, lds, bh >> 4, bh & 15, qb, (bf16_t*)(ws + WS_QF), (const bf16_t*)(ws + WS_KF), (const bf16_t*)(ws + WS_VTF), (const float*)(ws + WS_FC), a.in[13], a.in[14]); }
        }
    }
    SEAM(7);
    if (IN(8)) { EpiSig E{(bf16_t*)(ws + WS_SG), bmix}; RUN_GEMM(EpiSig, E, U, ws + WS_BTG, MTOK, 2048, 1024); }
    SEAM(8);
    if (IN(9)) { EpiMul E{(const bf16_t*)(ws + WS_SG), (bf16_t*)(ws + WS_T)}; RUN_GEMM_L(EpiMul, E, ws + WS_OM, ws + WS_BTA, MTOK, 1024, 1024, MK_SC1A, false); }
    SEAM(9);
    if (IN(9) || IN(10)) { EpiMerge E{(const bf16_t*)(ws + WS_SG), (const bf16_t*)(ws + WS_T), (bf16_t*)(ws + WS_MRG), cbw}; RUN_GEMM_L(EpiMerge, E, ws + WS_QF, ws + WS_BTB, MTOK, 1024, 1024, MK_SC1A, false); }
    SEAM(10);
    if (IN(11)) { EpiRes E{out, out, mod + 5 * 1024, 1.0f, cbo, true}; RUN_GEMM_L(EpiRes, E, ws + WS_MRG, ws + WS_BTO, MTOK, 1024, 1024, MK_SC1A, false); }
    SEAM(11);
    if (IN(12)) norm_phase(cbo, out, a.in[18], mod + 7 * 1024, mod + 6 * 1024, (bf16_t*)(ws + WS_QF), gw, NGW, lane);
    SEAM(12);
    if (IN(13)) { EpiSwiglu E{HID}; RUN_GEMM(EpiSwiglu, E, ws + WS_QF, ws + WS_BT2I, MTOK, 5632, 1024); }
    SEAM(13);
    if (IN(14)) { EpiRes E{out, out, mod + 8 * 1024, 0.5f, cbo, true}; RUN_GEMM_L(EpiRes, E, HID, ws + WS_BT2O, MTOK, 1024, 2816, MK_SC1A, false); }

    if (step + 1 < a.nsteps) xcd_barrier(bar);
    }
#undef IN
#undef SEAM
#undef RUN_GEMM
#undef RUN_GEMM_X
}

extern "C" void kernel_launch(void* const* d_in, const int* in_sizes, int n_in, void* d_out, int out_size, void* d_ws, size_t ws_size, hipStream_t stream) {
    static int grid = 0;
    if (grid == 0) {
        if (n_in != 21 || out_size != MTOK * DM || ws_size < WS_NEED) { fprintf(stderr, "kernel_launch: unexpected sizes n_in %d out %d ws %zu\n", n_in, out_size, ws_size); grid = -1; return; }
        int dev = 0, cus = 0, per_cu = 0;
        hipGetDevice(&dev); hipDeviceGetAttribute(&cus, hipDeviceAttributeMultiprocessorCount, dev);
        hipFuncSetAttribute((const void*)fwd, hipFuncAttributeMaxDynamicSharedMemorySize, LDS_BYTES);
        hipOccupancyMaxActiveBlocksPerMultiprocessor(&per_cu, (const void*)fwd, 512, LDS_BYTES);
        (void)hipGetLastError();
        if (per_cu < 1) per_cu = 1;
        grid = cus * per_cu;
        fprintf(stderr, "kernel_launch: cus %d per_cu %d grid %d ws %zu\n", cus, per_cu, grid, ws_size);
    }
    if (grid < 0) return;
    hipMemsetAsync((char*)d_ws + WS_CNT, 0, 65536, stream);
    Args a{};
    for (int i = 0; i < 21; ++i) a.in[i] = (const float*)d_in[i];
    a.out = (float*)d_out; a.ws = (unsigned char*)d_ws;
#if MK_SINGLE
#ifndef MK_SCHED
#define MK_SCHED {0,1,2,3,4,5,6,7,8,9,11,12,13,14}
#endif
    { const unsigned char sc[] = MK_SCHED; a.nsteps = (int)sizeof(sc); for (int i = 0; i < a.nsteps; ++i) a.sched[i] = sc[i]; }
    void* args[] = {&a};
    hipError_t e = hipLaunchCooperativeKernel((const void*)fwd, dim3(grid), dim3(512), args, LDS_BYTES, stream);
    if (e != hipSuccess) fprintf(stderr, "cooperative launch failed: %s (grid %d)\n", hipGetErrorString(e), grid);
#endif
}
```
